# Optimizing an MI355X kernel written in HIP

```python
import jax, jax.numpy as jnp
from jax import lax
import numpy as np

D_MODEL = 1024
BATCH = 8
SEQ = 4096
DEPTH = 2
DEC_BATCH = 16
DEC_SEQ = 32
PAST_LEN = 4096

CHUNK = 64
N_MEM = 256
MEM_HEADS = 4
MEM_HEAD_DIM = D_MODEL // MEM_HEADS
D_FF = 2816
LRU_WIDTH = D_MODEL // 2
LRU_BLOCKS = 8
LRU_BLOCK = LRU_WIDTH // LRU_BLOCKS
CONV_WIDTH = 4
LRU_C = 8.0
RET_HEADS = 4
RET_WIDTH = D_MODEL // 2
RET_HEAD_DIM = RET_WIDTH // RET_HEADS
ROPE_BASE = 10000.0
L0_IN = 2 * LRU_WIDTH + 4 * RET_WIDTH
RWKV_HEAD = 64
RWKV_HEADS = D_MODEL // RWKV_HEAD
LORA_W = 64
LORA_A = 64
LORA_G = 128
LN_EPS = 1e-5
RWKV_GN_EPS = 64e-5
ALPHA = (2 * DEPTH) ** 0.25
BETA = (8 * DEPTH) ** -0.25

kernel_name = "hybrid_streaming_encoder_step"


def layer_norm(x, g, b, eps=LN_EPS):
    xf = x.astype(jnp.float32)
    mu = xf.mean(-1, keepdims=True)
    var = jnp.square(xf - mu).mean(-1, keepdims=True)
    return ((xf - mu) * lax.rsqrt(var + eps) * g + b).astype(x.dtype)


def post_norm(x, sub, g, b):
    return layer_norm(ALPHA * x + sub, g, b)


def swiglu(x, w_up, w_down):
    gate, up = jnp.split(x @ w_up, 2, axis=-1)
    return (jax.nn.silu(gate) * up) @ w_down


def causal_conv(x, buf, w, b):
    T = x.shape[1]
    xpad = jnp.concatenate([buf.astype(x.dtype), x], axis=1)
    y = b + sum(xpad[:, j:j + T] * w[j] for j in range(CONV_WIDTH))
    return y, xpad[:, T:]


def rg_lru(x, h0, w_a, b_a, w_x, b_x, lam):
    B, T, _ = x.shape
    xb = x.reshape(B, T, LRU_BLOCKS, LRU_BLOCK)
    r = jax.nn.sigmoid(jnp.einsum('btgi,gij->btgj', xb, w_a).reshape(B, T, LRU_WIDTH) + b_a)
    i = jax.nn.sigmoid(jnp.einsum('btgi,gij->btgj', xb, w_x).reshape(B, T, LRU_WIDTH) + b_x)
    log_a = -LRU_C * jax.nn.softplus(-lam.astype(jnp.float32)) * r.astype(jnp.float32)
    a = jnp.exp(log_a)
    u = jnp.sqrt(-jnp.expm1(2.0 * log_a)) * (i * x).astype(jnp.float32)
    u = u.at[:, 0].add(a[:, 0] * h0.astype(jnp.float32))

    def combine(c1, c2):
        a1, b1 = c1
        a2, b2 = c2
        return a1 * a2, a2 * b1 + b2

    _, h = lax.associative_scan(combine, (a, u), axis=1)
    return h.astype(x.dtype), h[:, -1].astype(h0.dtype)


def rotary(x, pos):
    half = x.shape[-1] // 2
    inv_freq = ROPE_BASE ** (-jnp.arange(half, dtype=jnp.float32) / half)
    ang = pos.astype(jnp.float32)[:, None] * inv_freq[None, :]
    cos = jnp.cos(ang)[None, :, None, :]
    sin = jnp.sin(ang)[None, :, None, :]
    xf = x.astype(jnp.float32)
    x1, x2 = xf[..., :half], xf[..., half:]
    return jnp.concatenate([x1 * cos - x2 * sin, x1 * sin + x2 * cos], axis=-1)


def retention(q, k, v, s0, chunk):
    B, T, H, dk = q.shape
    dv = v.shape[-1]
    n = T // chunk
    log_g = jnp.log1p(-(2.0 ** (-5.0 - jnp.arange(H, dtype=jnp.float32))))
    qc = q.astype(jnp.float32).reshape(B, n, chunk, H, dk)
    kc = (k.astype(jnp.float32) * dk ** -0.5).reshape(B, n, chunk, H, dk)
    vc = v.astype(jnp.float32).reshape(B, n, chunk, H, dv)
    idx = jnp.arange(chunk, dtype=jnp.float32)
    diff = idx[:, None] - idx[None, :]
    dmask = jnp.where(diff >= 0, jnp.exp(log_g[:, None, None] * jnp.maximum(diff, 0.0)), 0.0)
    scores = jnp.einsum('bnihd,bnjhd->bnhij', qc, kc) * dmask
    inner = jnp.einsum('bnhij,bnjhv->bnihv', scores, vc)
    zeta = jnp.exp(log_g[:, None] * (chunk - 1.0 - idx)[None, :])
    kv_chunk = jnp.einsum('bnjhd,hj,bnjhv->bnhdv', kc, zeta, vc)
    chunk_decay = jnp.exp(log_g * chunk)[None, :, None, None]

    def step(S, kv):
        return chunk_decay * S + kv, S

    s_last, s_prev = lax.scan(step, s0.astype(jnp.float32), jnp.moveaxis(kv_chunk, 1, 0))
    s_prev = jnp.moveaxis(s_prev, 0, 1)
    xi = jnp.exp(log_g[None, :] * (idx[:, None] + 1.0))[:, :, None]
    cross = jnp.einsum('bnihd,bnhdv->bnihv', qc, s_prev) * xi
    return (inner + cross).reshape(B, T, H, dv), s_last


def mixer_ab(x, pos, conv_buf, h0, s0, w_in, conv_w, conv_b, lru_wa, lru_ba, lru_wx, lru_bx,
             lru_lambda, ret_gn_g, ret_gn_b, w_out):
    B, T, _ = x.shape
    xa, ga, q, k, v, g = jnp.split(x @ w_in, 6, axis=-1)
    xc, new_buf = causal_conv(xa, conv_buf, conv_w, conv_b)
    h, h_last = rg_lru(xc, h0, lru_wa, lru_ba, lru_wx, lru_bx, lru_lambda)
    ya = h * jax.nn.gelu(ga)
    q = rotary(q.reshape(B, T, RET_HEADS, RET_HEAD_DIM), pos)
    k = rotary(k.reshape(B, T, RET_HEADS, RET_HEAD_DIM), pos)
    v = v.reshape(B, T, RET_HEADS, RET_HEAD_DIM)
    o, s_last = retention(q, k, v, s0, min(CHUNK, T))
    o = layer_norm(o, ret_gn_g.reshape(RET_HEADS, RET_HEAD_DIM), ret_gn_b.reshape(RET_HEADS, RET_HEAD_DIM))
    yb = o.reshape(B, T, RET_WIDTH).astype(x.dtype) * jax.nn.silu(g)
    y = jnp.concatenate([ya, yb], axis=-1) @ w_out
    return y, (new_buf, h_last, s_last.astype(s0.dtype))


def mixer_c(x, shift_buf, s0, mu, w_rkv, w0, w1, w2, a0, a1, a2, g1, g2, k_k, k_a, r_k,
            gn_g, gn_b, w_out):
    B, T, D = x.shape
    f32 = jnp.float32
    x_prev = jnp.concatenate([shift_buf.astype(x.dtype), x[:, :-1]], axis=1)
    xm = x[None] + (x_prev - x)[None] * mu[:, None, None, :]
    rkv = jnp.einsum('pbtd,pde->pbte', xm[:3], w_rkv)
    r, k, v = rkv[0], rkv[1], rkv[2]
    w = -jax.nn.softplus(-(w0 + jnp.tanh(xm[3] @ w1) @ w2)) - 0.5
    decay = jnp.exp(-jnp.exp(w.astype(f32)))
    iclr = jax.nn.sigmoid(a0 + (xm[4] @ a1) @ a2)
    g = jax.nn.sigmoid(xm[5] @ g1) @ g2
    hs = lambda t: t.reshape(B, T, RWKV_HEADS, RWKV_HEAD).astype(f32)
    r, k, v, decay, iclr = hs(r), hs(k), hs(v), hs(decay), hs(iclr)
    kk = k * k_k.reshape(RWKV_HEADS, RWKV_HEAD)
    kk = kk / jnp.maximum(jnp.linalg.norm(kk, axis=-1, keepdims=True), 1e-12)
    k = k * (1.0 + (iclr - 1.0) * k_a.reshape(RWKV_HEADS, RWKV_HEAD))

    def step(S, inp):
        r_t, w_t, k_t, v_t, kk_t, b_t = inp
        sa = jnp.einsum('bhvk,bhk->bhv', S, -kk_t)
        S = S * w_t[:, :, None, :] + sa[..., None] * b_t[:, :, None, :] + v_t[..., None] * k_t[:, :, None, :]
        return S, jnp.einsum('bhvk,bhk->bhv', S, r_t)

    tm = lambda t: jnp.moveaxis(t, 1, 0)
    s_last, o = lax.scan(step, s0.astype(f32), (tm(r), tm(decay), tm(k), tm(v), tm(kk), tm(kk * iclr)))
    o = jnp.moveaxis(o, 0, 1)
    o = layer_norm(o, gn_g.reshape(RWKV_HEADS, RWKV_HEAD), gn_b.reshape(RWKV_HEADS, RWKV_HEAD), RWKV_GN_EPS)
    o = o + (r * k * r_k).sum(-1, keepdims=True) * v
    y = (o.reshape(B, T, D).astype(x.dtype) * g) @ w_out
    return y, (x[:, -1:].astype(shift_buf.dtype), s_last.astype(s0.dtype))


def cross_attn(x, mem_k, mem_v, w_q, w_o):
    B, T, D = x.shape
    q = (x @ w_q).reshape(B, T, MEM_HEADS, MEM_HEAD_DIM)
    s = jnp.einsum('bthd,bmhd->bhtm', q, mem_k).astype(jnp.float32) * MEM_HEAD_DIM ** -0.5
    p = jax.nn.softmax(s, axis=-1).astype(x.dtype)
    o = jnp.einsum('bhtm,bmhd->bthd', p, mem_v).reshape(B, T, D)
    return o @ w_o


def run_trunk(x, pos, mem_k, mem_v, states, ln_g, ln_b, ffn_up, ffn_down, xa_q, xa_o, mixer_params):
    new_states = []
    for layer in range(DEPTH):
        x = post_norm(x, 0.5 * swiglu(x, ffn_up[layer, 0], ffn_down[layer, 0]), ln_g[layer, 0], ln_b[layer, 0])
        if layer % 2 == 0:
            y, st = mixer_ab(x, pos, *states[layer], *mixer_params[layer])
        else:
            y, st = mixer_c(x, *states[layer], *mixer_params[layer])
        x = post_norm(x, y, ln_g[layer, 1], ln_b[layer, 1])
        x = post_norm(x, cross_attn(x, mem_k[layer], mem_v[layer], xa_q[layer], xa_o[layer]),
                      ln_g[layer, 2], ln_b[layer, 2])
        x = post_norm(x, 0.5 * swiglu(x, ffn_up[layer, 1], ffn_down[layer, 1]), ln_g[layer, 3], ln_b[layer, 3])
        new_states.append(st)
    return x, new_states


def setup_inputs(seed: int = 0) -> dict:
    key = jax.random.key(seed)
    ks = iter(jax.random.split(key, 64))
    f32 = jnp.float32

    def nrm(shape, scale):
        return scale * jax.random.normal(next(ks), shape, f32)

    def uni(shape, lo, hi):
        return jax.random.uniform(next(ks), shape, f32, minval=lo, maxval=hi)

    D = D_MODEL
    lam_p = uni((LRU_WIDTH,), 0.9, 0.999)
    return {
        'x_prompt': nrm((BATCH, SEQ, D), 1.0),
        'x_sample': nrm((DEC_BATCH, DEC_SEQ, D), 1.0),
        'mem_prompt': nrm((BATCH, N_MEM, D), 1.0),
        'state_conv0': nrm((DEC_BATCH, CONV_WIDTH - 1, LRU_WIDTH), 1.0),
        'state_lru0': nrm((DEC_BATCH, LRU_WIDTH), 0.5),
        'state_ret0': nrm((DEC_BATCH, RET_HEADS, RET_HEAD_DIM, RET_HEAD_DIM), 0.5),
        'state_shift1': nrm((DEC_BATCH, 1, D), 1.0),
        'state_wkv1': nrm((DEC_BATCH, RWKV_HEADS, RWKV_HEAD, RWKV_HEAD), 0.5),
        'cache_mem_k': nrm((DEPTH, DEC_BATCH, N_MEM, MEM_HEADS, MEM_HEAD_DIM), 1.0),
        'cache_mem_v': nrm((DEPTH, DEC_BATCH, N_MEM, MEM_HEADS, MEM_HEAD_DIM), 1.0),
        'ln_g': 1.0 + nrm((DEPTH, 4, D), 0.02),
        'ln_b': nrm((DEPTH, 4, D), 0.02),
        'ffn_up': nrm((DEPTH, 2, D, 2 * D_FF), D ** -0.5),
        'ffn_down': nrm((DEPTH, 2, D_FF, D), BETA * D_FF ** -0.5),
        'xa_q': nrm((DEPTH, D, D), D ** -0.5),
        'xa_k': nrm((DEPTH, D, D), D ** -0.5),
        'xa_v': nrm((DEPTH, D, D), D ** -0.5),
        'xa_o': nrm((DEPTH, D, D), BETA * D ** -0.5),
        'l0_w_in': nrm((D, L0_IN), D ** -0.5),
        'l0_conv_w': nrm((CONV_WIDTH, LRU_WIDTH), CONV_WIDTH ** -0.5),
        'l0_conv_b': nrm((LRU_WIDTH,), 0.01),
        'l0_lru_wa': nrm((LRU_BLOCKS, LRU_BLOCK, LRU_BLOCK), LRU_BLOCK ** -0.5),
        'l0_lru_ba': nrm((LRU_WIDTH,), 0.01),
        'l0_lru_wx': nrm((LRU_BLOCKS, LRU_BLOCK, LRU_BLOCK), LRU_BLOCK ** -0.5),
        'l0_lru_bx': nrm((LRU_WIDTH,), 0.01),
        'l0_lru_lambda': jnp.log(lam_p) - jnp.log1p(-lam_p),
        'l0_ret_gn_g': 1.0 + nrm((RET_WIDTH,), 0.02),
        'l0_ret_gn_b': nrm((RET_WIDTH,), 0.02),
        'l0_w_out': nrm((LRU_WIDTH + RET_WIDTH, D), BETA * (LRU_WIDTH + RET_WIDTH) ** -0.5),
        'l1_mu': uni((6, D), 0.0, 1.0),
        'l1_w_rkv': nrm((3, D, D), D ** -0.5),
        'l1_w0': uni((D,), -6.5, -1.5),
        'l1_w1': nrm((D, LORA_W), D ** -0.5),
        'l1_w2': nrm((LORA_W, D), 0.1 * LORA_W ** -0.5),
        'l1_a0': nrm((D,), 0.1),
        'l1_a1': nrm((D, LORA_A), D ** -0.5),
        'l1_a2': nrm((LORA_A, D), 0.1 * LORA_A ** -0.5),
        'l1_g1': nrm((D, LORA_G), D ** -0.5),
        'l1_g2': nrm((LORA_G, D), LORA_G ** -0.5),
        'l1_k_k': 0.85 + nrm((D,), 0.05),
        'l1_k_a': 1.0 + nrm((D,), 0.05),
        'l1_r_k': nrm((RWKV_HEADS, RWKV_HEAD), 0.1),
        'l1_gn_g': 1.0 + nrm((D,), 0.02),
        'l1_gn_b': nrm((D,), 0.02),
        'l1_w_out': nrm((D, D), BETA * D ** -0.5),
    }


def reference(x_prompt, x_sample, mem_prompt, state_conv0, state_lru0, state_ret0, state_shift1, state_wkv1,
              cache_mem_k, cache_mem_v, ln_g, ln_b, ffn_up, ffn_down, xa_q, xa_k, xa_v, xa_o,
              l0_w_in, l0_conv_w, l0_conv_b, l0_lru_wa, l0_lru_ba, l0_lru_wx, l0_lru_bx, l0_lru_lambda,
              l0_ret_gn_g, l0_ret_gn_b, l0_w_out, l1_mu, l1_w_rkv, l1_w0, l1_w1, l1_w2, l1_a0, l1_a1, l1_a2,
              l1_g1, l1_g2, l1_k_k, l1_k_a, l1_r_k, l1_gn_g, l1_gn_b, l1_w_out):
    params_ab = (l0_w_in, l0_conv_w, l0_conv_b, l0_lru_wa, l0_lru_ba, l0_lru_wx, l0_lru_bx, l0_lru_lambda,
                 l0_ret_gn_g, l0_ret_gn_b, l0_w_out)
    params_c = (l1_mu, l1_w_rkv, l1_w0, l1_w1, l1_w2, l1_a0, l1_a1, l1_a2, l1_g1, l1_g2, l1_k_k, l1_k_a,
                l1_r_k, l1_gn_g, l1_gn_b, l1_w_out)
    mixer_params = (params_ab, params_c)

    Bp, Tp, _ = x_prompt.shape
    dt = x_prompt.dtype
    pos_p = jnp.arange(Tp, dtype=jnp.int32)
    mem_k_p = jnp.einsum('bmd,lde->lbme', mem_prompt, xa_k).reshape(DEPTH, Bp, N_MEM, MEM_HEADS, MEM_HEAD_DIM)
    mem_v_p = jnp.einsum('bmd,lde->lbme', mem_prompt, xa_v).reshape(DEPTH, Bp, N_MEM, MEM_HEADS, MEM_HEAD_DIM)
    zero_states = ((jnp.zeros((Bp, CONV_WIDTH - 1, LRU_WIDTH), dt), jnp.zeros((Bp, LRU_WIDTH), dt),
                    jnp.zeros((Bp, RET_HEADS, RET_HEAD_DIM, RET_HEAD_DIM), dt)),
                   (jnp.zeros((Bp, 1, D_MODEL), dt), jnp.zeros((Bp, RWKV_HEADS, RWKV_HEAD, RWKV_HEAD), dt)))
    y_prompt, st_p = run_trunk(x_prompt, pos_p, mem_k_p, mem_v_p, zero_states, ln_g, ln_b, ffn_up, ffn_down,
                               xa_q, xa_o, mixer_params)

    Ts = x_sample.shape[1]
    pos_s = PAST_LEN + jnp.arange(Ts, dtype=jnp.int32)
    sample_states = ((state_conv0, state_lru0, state_ret0), (state_shift1, state_wkv1))
    y_sample, st_s = run_trunk(x_sample, pos_s, cache_mem_k, cache_mem_v, sample_states, ln_g, ln_b, ffn_up,
                               ffn_down, xa_q, xa_o, mixer_params)

    (p_conv0, p_lru0, p_ret0), (p_shift1, p_wkv1) = st_p
    (s_conv0, s_lru0, s_ret0), (s_shift1, s_wkv1) = st_s
    return (y_prompt, y_sample, mem_k_p, mem_v_p, p_conv0, p_lru0, p_ret0, p_shift1, p_wkv1,
            s_conv0, s_lru0, s_ret0, s_shift1, s_wkv1)
```

```cpp
#include <hip/hip_runtime.h>
#include <hip/hip_cooperative_groups.h>
#include <cstdio>
#include <cstdint>
namespace cg = cooperative_groups;

#define LAS __attribute__((address_space(3)))
#define DEV __device__ __forceinline__
typedef unsigned short bf16_t;
typedef short bf16x8 __attribute__((ext_vector_type(8)));
typedef float f32x4 __attribute__((ext_vector_type(4)));
typedef unsigned u32x4 __attribute__((ext_vector_type(4)));
typedef unsigned u32x2 __attribute__((ext_vector_type(2)));

constexpr int MTOK = 33280, DM = 1024, MPROMPT = 32768, NTHR = 512;
constexpr int LDS_BYTES = 147456;
#define DBG_C 64
#define DBG_C_RET 64
#define DBG_SCANREP 1
#define DBG_MIXREP 1
#define DBG_GREP 1
#define DBG_SYNCREP 0
#define DBG_LNREP 1
#define DBG_ATTREP 1
#define DBG_PREPREP 1
#define DBG_YSCALE 1.0f
#define DBG_SHSCALE 1.0f
#define DBG_WKVSCALE 1.0f
#define DBG_RETSCALE 1.0f
#define DBG_LRUSCALE 1.0f
#define DBG_CONVSCALE 1.0f
constexpr size_t E_EL = (size_t)MTOK * DM;
constexpr size_t W_UP = 0;
constexpr size_t W_DN = W_UP + (size_t)4 * 5632 * 1024;
constexpr size_t W_XQ = W_DN + (size_t)4 * 1024 * 2816;
constexpr size_t W_XO = W_XQ + (size_t)2 * 1048576;
constexpr size_t W_KV = W_XO + (size_t)2 * 1048576;
constexpr size_t W_IN = W_KV + (size_t)4096 * 1024;
constexpr size_t W_O0 = W_IN + (size_t)3072 * 1024;
constexpr size_t W_P1 = W_O0 + (size_t)1048576;
constexpr size_t W_L2 = W_P1 + (size_t)3328 * 2048;
constexpr size_t W_O1 = W_L2 + (size_t)3072 * 256;
constexpr size_t W_END = W_O1 + (size_t)1048576;
constexpr size_t KV_EL = (size_t)2 * 24 * 256 * 1024;
constexpr size_t WS_KB = W_END * 2;
constexpr size_t WS_VT = WS_KB + KV_EL * 2;
constexpr size_t WS_XB = WS_VT + KV_EL * 2;
constexpr size_t WS_A1 = WS_XB + E_EL * 2;
constexpr size_t WS_A2 = WS_A1 + E_EL * 2;
constexpr size_t WS_A3 = WS_A2 + E_EL * 2;
constexpr size_t WS_A4 = WS_A3 + E_EL * 2;
constexpr size_t WS_HL = WS_A4 + E_EL * 2;
constexpr size_t WS_END = WS_HL + (size_t)MTOK * 256 * 2;
constexpr size_t O_Y = 0, O_MK = 34078720, O_MV = 38273024, O_PCONV = 42467328, O_PLRU = 42479616, O_PRET = 42483712,
                 O_PSHIFT = 43008000, O_PWKV = 43016192, O_SCONV = 43540480, O_SLRU = 43565056, O_SRET = 43573248,
                 O_SSHIFT = 44621824, O_SWKV = 44638208;

struct KP { const float* in[45]; float* out; unsigned char* ws; int ph_lo, ph_hi; };

DEV int ltid() { int t = threadIdx.x; asm volatile("" : "+v"(t)); return t; }
DEV const float* pin(const KP& P, int k) { asm volatile("" : "+s"(k)); return P.in[k]; }
#define PIN(k) pin(P, k)
typedef float f32x2_t __attribute__((ext_vector_type(2)));
typedef __bf16 bf16x2_t __attribute__((ext_vector_type(2)));
DEV unsigned pk2(float lo, float hi) { const f32x2_t v = {lo, hi}; return __builtin_bit_cast(unsigned, __builtin_convertvector(v, bf16x2_t)); }
DEV float bflo(unsigned u) { return __uint_as_float(u << 16); }
DEV float bfhi(unsigned u) { return __uint_as_float(u & 0xffff0000u); }
DEV float bf1(bf16_t b) { return __uint_as_float(((unsigned)b) << 16); }
DEV bf16_t f2bf(float f) { return (bf16_t)(pk2(f, f) & 0xffffu); }
DEV float sigmoidf_(float x) { return __builtin_amdgcn_rcpf(1.f + __expf(-x)); }
DEV float tanhf_(float x) { return 1.f - 2.f / (__expf(2.f * x) + 1.f); }
template <int CTRL> DEV float dppf(float v) { return __builtin_bit_cast(float, __builtin_amdgcn_update_dpp(0, __builtin_bit_cast(int, v), CTRL, 0xf, 0xf, true)); }
DEV float red8(float v) { v += dppf<0xB1>(v); v += dppf<0x4E>(v); v += dppf<0x141>(v); return v; }
DEV float red16(float v) { v = red8(v); v += dppf<0x140>(v); return v; }
DEV float wave_sum(float v) {
#pragma unroll
    for (int o = 1; o < 64; o <<= 1) v += __shfl_xor(v, o);
    return v;
}
DEV void unpack8(u32x4 u, float* f) { f[0] = bflo(u.x); f[1] = bfhi(u.x); f[2] = bflo(u.y); f[3] = bfhi(u.y); f[4] = bflo(u.z); f[5] = bfhi(u.z); f[6] = bflo(u.w); f[7] = bfhi(u.w); }
DEV u32x4 pack8(const float* f) { u32x4 o; o.x = pk2(f[0], f[1]); o.y = pk2(f[2], f[3]); o.z = pk2(f[4], f[5]); o.w = pk2(f[6], f[7]); return o; }
DEV f32x4 mfma16(bf16x8 a, bf16x8 b, f32x4 c) { return __builtin_amdgcn_mfma_f32_16x16x32_bf16(a, b, c, 0, 0, 0); }

namespace pg8 {
constexpr int BM = 256, BK = 64, HALF = 128, HTB = HALF * BK * 2, NXCD = 8, WGM = 8;
DEV int lds_byte(int r, int c) { const int st = (r >> 4) * 2 + (c >> 5), rr = r & 15, cc = c & 31, ob = rr * 64 + cc * 2; return st * 1024 + (ob ^ (((ob >> 9) & 1) << 5)); }
DEV void stage_rc(int b, int& R, int& C) { const int st = b / 1024, sb = b % 1024, swz = sb ^ (((sb >> 9) & 1) << 5); R = (st >> 1) * 16 + swz / 64; C = (st & 1) * 32 + (swz % 64) / 2; }
DEV int perm32(int rho) { const int n = rho >> 4, i = rho & 15; return 8 * (i >> 2) + 4 * n + (i & 3); }
struct Unit { int pm, pn; };
struct Gemm { const bf16_t* A0; const bf16_t* A1; const bf16_t* Bt; int lda, K, nt0, M, N; };
struct StaticOrder {
    int nM, nN, nwg, G, c;
    DEV void init(int M, int N, int G_, int c_) { nM = M / BM; nN = N / BM; nwg = nM * nN; G = G_; c = c_; }
    DEV bool next(int i, Unit& u) const {
        const long L = (long)i * G + c; if (L >= nwg) return false;
        int wgid = (int)L; { const int q = nwg / NXCD, r = nwg % NXCD, xcd = wgid % NXCD, off = wgid / NXCD; wgid = (xcd < r ? xcd * (q + 1) : r * (q + 1) + (xcd - r) * q) + off; }
        const int nig = WGM * nN, gid = wgid / nig, fm = gid * WGM, gsz = (nM - fm) < WGM ? (nM - fm) : WGM;
        u.pm = fm + ((wgid % nig) % gsz); u.pn = (wgid % nig) / gsz; return true;
    }
};

template <class Epi>
DEV void gemm_phase(LAS unsigned char* lds, const Gemm g, const StaticOrder& S, const Epi& E) {
    const int tid = ltid(), wid = __builtin_amdgcn_readfirstlane(tid >> 6), lane = tid & 63, wr = wid >> 2, wc = wid & 3, fr = lane & 15, fq = lane >> 4;
    const int K = g.K, nt = K / BK, lda = g.lda, nt0 = g.nt0;
    unsigned voffA[2], voffB[2];
#pragma unroll
    for (int i = 0; i < 2; ++i) { int R, C; stage_rc(tid * 16 + i * 8192, R, C); const int Rb = (R & ~31) + perm32(R & 31);
        voffA[i] = (unsigned)(R * lda + C) * 2u; voffB[i] = (unsigned)(Rb * K + C) * 2u; }
    const size_t kstep = (size_t)(BK * 2);
    const size_t hstepA = (size_t)HALF * lda * 2, hstepB = (size_t)HALF * K * 2;
    const size_t tstepA = 2 * hstepA, tstepB = 2 * hstepB;
    const unsigned ldsw = (unsigned)wid * 1024u;
    const int aoff = lds_byte(wr * 64 + fr, fq * 8), boff = lds_byte(wc * 32 + fr, fq * 8);
    const char* const gA0 = (const char*)g.A0; const char* const gA1 = (const char*)g.A1 - (size_t)nt0 * kstep;
#define PG8_AK(rowoff, kt) (((kt) < nt0 ? gA0 : gA1) + (rowoff) + (size_t)(kt) * kstep)
#define PG8_SA(b, h) (((b) * 2 + (h)) * HTB)
#define PG8_SB(b, h) ((4 + (b) * 2 + (h)) * HTB)
#define PG8_STAGE(bufoff, gbase, voff) do { _Pragma("unroll") for (int _i = 0; _i < 2; ++_i) \
        __builtin_amdgcn_global_load_lds((const unsigned*)((const char*)(gbase) + (voff)[_i]), (LAS unsigned*)(lds + (bufoff) + ldsw + _i * 8192), 16, 0, 0); } while (0)
#define PG8_LDA(dst, b, h) do { _Pragma("unroll") for (int m = 0; m < 4; ++m) _Pragma("unroll") for (int k = 0; k < 2; ++k) dst[m][k] = *(const LAS bf16x8*)(lds + PG8_SA(b, h) + aoff + m * 2048 + k * 1024); } while (0)
#define PG8_LDB(dst, b, h) do { _Pragma("unroll") for (int n = 0; n < 2; ++n) _Pragma("unroll") for (int k = 0; k < 2; ++k) dst[n][k] = *(const LAS bf16x8*)(lds + PG8_SB(b, h) + boff + n * 2048 + k * 1024); } while (0)
#define PG8_MMA(ai, bj, At, Bt) do { __builtin_amdgcn_s_setprio(1); _Pragma("unroll") for (int m = 0; m < 4; ++m) _Pragma("unroll") for (int n = 0; n < 2; ++n) _Pragma("unroll") for (int k = 0; k < 2; ++k) \
        acc[ai][bj][m][n] = __builtin_amdgcn_mfma_f32_16x16x32_bf16(Bt[n][k], At[m][k], acc[ai][bj][m][n], 0, 0, 0); __builtin_amdgcn_s_setprio(0); } while (0)
#define PG8_WAIT_V(n) asm volatile("s_waitcnt vmcnt(" #n ")" ::: "memory")
#define PG8_WAIT_L(n) asm volatile("s_waitcnt lgkmcnt(" #n ")" ::: "memory")
#define PG8_BAR __builtin_amdgcn_s_barrier()
#define PG8_SCHED __builtin_amdgcn_sched_barrier(0)
    Unit cur, nxt; int ui = 0;
    if (!S.next(0, cur)) return;
    f32x4 acc[2][2][4][2];
#pragma unroll
    for (int a = 0; a < 2; ++a)
#pragma unroll
        for (int b = 0; b < 2; ++b)
#pragma unroll
            for (int m = 0; m < 4; ++m)
#pragma unroll
                for (int n = 0; n < 2; ++n) acc[a][b][m][n] = (f32x4){0.f, 0.f, 0.f, 0.f};
    bf16x8 At[4][2], B0[2][2], B1[2][2];
    size_t cAo = (size_t)cur.pm * tstepA; const char* cB = (const char*)g.Bt + (size_t)cur.pn * tstepB;
    { const char* a0p = PG8_AK(cAo, 0); const char* a1p = PG8_AK(cAo, 1);
      PG8_STAGE(PG8_SB(0, 0), cB, voffB); PG8_STAGE(PG8_SA(0, 0), a0p, voffA); PG8_STAGE(PG8_SB(0, 1), cB + hstepB, voffB); PG8_STAGE(PG8_SA(0, 1), a0p + hstepA, voffA);
      if (wr == 1) PG8_BAR;
      PG8_WAIT_V(4); PG8_BAR;
      PG8_STAGE(PG8_SB(1, 0), cB + kstep, voffB); PG8_STAGE(PG8_SA(1, 0), a1p, voffA); PG8_STAGE(PG8_SB(1, 1), cB + hstepB + kstep, voffB);
      PG8_WAIT_V(6); PG8_BAR; }
    for (;;) {
        const bool has_next = S.next(ui + 1, nxt);
        const size_t nAo = has_next ? (size_t)nxt.pm * tstepA : cAo; const char* nB = has_next ? (const char*)g.Bt + (size_t)nxt.pn * tstepB : cB;
        for (int t = 0; t < nt; t += 2) {
            const bool last = (t == nt - 2);
            const char* a1 = PG8_AK(cAo, t + 1);
            const char* a2 = last ? PG8_AK(nAo, 0) : PG8_AK(cAo, t + 2); const char* b2 = last ? nB : cB + (size_t)(t + 2) * kstep;
            const char* a3 = last ? PG8_AK(nAo, 1) : PG8_AK(cAo, t + 3); const char* b3 = b2 + kstep;
            PG8_LDB(B0, 0, 0); PG8_SCHED; PG8_LDA(At, 0, 0); PG8_STAGE(PG8_SA(1, 1), a1 + hstepA, voffA);
            PG8_WAIT_L(8); PG8_BAR; PG8_WAIT_L(0); PG8_MMA(0, 0, At, B0); PG8_BAR; PG8_SCHED;
            PG8_LDB(B1, 0, 1); PG8_STAGE(PG8_SB(0, 0), b2, voffB);
            PG8_BAR; PG8_WAIT_L(0); PG8_MMA(0, 1, At, B1); PG8_BAR;
            PG8_LDA(At, 0, 1); PG8_STAGE(PG8_SA(0, 0), a2, voffA);
            PG8_BAR; PG8_WAIT_L(0); PG8_MMA(1, 0, At, B0); PG8_BAR; PG8_SCHED;
            PG8_STAGE(PG8_SB(0, 1), b2 + hstepB, voffB);
            PG8_WAIT_V(6); PG8_BAR; PG8_MMA(1, 1, At, B1); PG8_BAR;
            PG8_LDB(B0, 1, 0); PG8_SCHED; PG8_LDA(At, 1, 0); PG8_STAGE(PG8_SA(0, 1), a2 + hstepA, voffA);
            PG8_WAIT_L(8); PG8_BAR; PG8_WAIT_L(0); PG8_MMA(0, 0, At, B0); PG8_BAR; PG8_SCHED;
            PG8_LDB(B1, 1, 1); PG8_STAGE(PG8_SB(1, 0), b3, voffB);
            PG8_BAR; PG8_WAIT_L(0); PG8_MMA(0, 1, At, B1); PG8_BAR;
            PG8_LDA(At, 1, 1); PG8_STAGE(PG8_SA(1, 0), a3, voffA);
            PG8_BAR; PG8_WAIT_L(0); PG8_MMA(1, 0, At, B0); PG8_BAR; PG8_SCHED;
            PG8_STAGE(PG8_SB(1, 1), b3 + hstepB, voffB);
            PG8_WAIT_V(6); PG8_BAR; PG8_MMA(1, 1, At, B1); PG8_BAR;
        }
        E(acc, cur, wr, wc, fr, fq);
        if (!has_next) break;
#pragma unroll
        for (int a = 0; a < 2; ++a)
#pragma unroll
            for (int b = 0; b < 2; ++b)
#pragma unroll
                for (int m = 0; m < 4; ++m)
#pragma unroll
                    for (int n = 0; n < 2; ++n) acc[a][b][m][n] = (f32x4){0.f, 0.f, 0.f, 0.f};
        cur = nxt; cAo = nAo; cB = nB; ++ui;
    }
    PG8_WAIT_V(0);
    if (wr == 0) PG8_BAR;
    PG8_BAR;
#undef PG8_AK
#undef PG8_SA
#undef PG8_SB
#undef PG8_STAGE
#undef PG8_LDA
#undef PG8_LDB
#undef PG8_MMA
#undef PG8_WAIT_V
#undef PG8_WAIT_L
#undef PG8_BAR
#undef PG8_SCHED
}
}

struct EpiP { bf16_t* o0; bf16_t* o1; bf16_t* o2; bf16_t* o3; float* f0; const float* v0; const float* v1; int ldc; float s; };
typedef f32x4 AccT[2][2][4][2];
template <int MODE> struct Epi {
    EpiP p;
    DEV void operator()(const AccT& acc, const pg8::Unit& u, int wr, int wc, int fr, int fq) const {
        const int row0 = u.pm * 256 + wr * 64 + fr;
        const int cl = wc * 32 + 8 * fq;
#pragma unroll
        for (int ai = 0; ai < 2; ++ai)
#pragma unroll
            for (int m = 0; m < 4; ++m) {
                const size_t row = (size_t)(row0 + ai * 128 + m * 16);
                if (MODE == 1) {
                    float h[8];
#pragma unroll
                    for (int n = 0; n < 2; ++n)
#pragma unroll
                        for (int i = 0; i < 4; ++i) { const float gt = acc[ai][0][m][n][i], up = acc[ai][1][m][n][i]; h[n * 4 + i] = gt * sigmoidf_(gt) * up; }
                    *(u32x4*)(p.o0 + row * 2816 + u.pn * 128 + cl) = pack8(h);
                } else {
#pragma unroll
                    for (int bj = 0; bj < 2; ++bj) {
                        float v[8];
#pragma unroll
                        for (int n = 0; n < 2; ++n)
#pragma unroll
                            for (int i = 0; i < 4; ++i) v[n * 4 + i] = acc[ai][bj][m][n][i];
                        const int col = u.pn * 256 + bj * 128 + cl;
                        if (MODE == 0) {
                            *(u32x4*)(p.o0 + row * p.ldc + col) = pack8(v);
                        } else if (MODE == 2) {
                            bf16_t* xp = p.o0 + row * 1024 + col; float x[8]; unpack8(*(const u32x4*)xp, x);
#pragma unroll
                            for (int i = 0; i < 8; ++i) x[i] = 1.41421356237f * x[i] + p.s * v[i];
                            *(u32x4*)xp = pack8(x);
                        } else if (MODE == 3) {
                            if (u.pn < 12) { bf16_t* base = p.o0 + (size_t)(u.pn >> 2) * E_EL;
                                *(u32x4*)(base + row * 1024 + (col & 1023)) = pack8(v);
                            } else { const int c = bj * 128 + cl;
                                if (bj == 1) {
#pragma unroll
                                    for (int i = 0; i < 8; ++i) v[i] = sigmoidf_(v[i]);
                                } else if (wc < 2) {
#pragma unroll
                                    for (int i = 0; i < 8; ++i) v[i] = tanhf_(v[i]);
                                }
                                *(u32x4*)(p.o3 + row * 256 + c) = pack8(v); }
                        } else if (MODE == 4) {
                            const int c = col & 1023;
                            if (u.pn < 4) {
#pragma unroll
                                for (int i = 0; i < 8; ++i) v[i] = 0.60653066f * sigmoidf_(p.v0[c + i] + v[i]);
                                *(u32x4*)(p.o0 + row * 1024 + c) = pack8(v);
                            } else if (u.pn < 8) {
#pragma unroll
                                for (int i = 0; i < 8; ++i) v[i] = sigmoidf_(p.v1[c + i] + v[i]);
                                *(u32x4*)(p.o1 + row * 1024 + c) = pack8(v);
                            } else *(u32x4*)(p.o2 + row * 1024 + c) = pack8(v);
                        } else if (MODE == 5) {
                            const int which = col >> 10, c = col & 1023, l = which & 1;
                            float* fo = p.f0 + (which < 2 ? O_MK : O_MV) + (size_t)l * 2097152 + row * 1024 + c;
                            *(f32x4*)fo = (f32x4){v[0], v[1], v[2], v[3]}; *(f32x4*)(fo + 4) = (f32x4){v[4], v[5], v[6], v[7]};
                            const int b = (int)(row >> 8), mem = (int)(row & 255);
                            if (which < 2) { *(u32x4*)(p.o0 + ((size_t)(l * 24 + b) * 256 + mem) * 1024 + c) = pack8(v); }
                            else { const int hh = c >> 8, d = c & 255; bf16_t* vt = p.o1 + ((size_t)((l * 24 + b) * 4 + hh) * 256 + d) * 256 + mem;
#pragma unroll
                                for (int i = 0; i < 8; ++i) vt[(size_t)i * 256] = f2bf(v[i]); }
                        }
                    }
                }
            }
    }
};

struct GD { pg8::Gemm g; EpiP ep; int mode; int coff; };
DEV void run_gemm(const GD& d, unsigned char* smem) {
    pg8::StaticOrder S; const int G = gridDim.x; S.init(d.g.M, d.g.N, G, (int)((blockIdx.x + d.coff) % G));
    LAS unsigned char* lds = (LAS unsigned char*)smem;
    switch (d.mode) {
        case 0: { Epi<0> e{d.ep}; pg8::gemm_phase(lds, d.g, S, e); } break;
        case 1: { Epi<1> e{d.ep}; pg8::gemm_phase(lds, d.g, S, e); } break;
        case 2: { Epi<2> e{d.ep}; pg8::gemm_phase(lds, d.g, S, e); } break;
        case 3: { Epi<3> e{d.ep}; pg8::gemm_phase(lds, d.g, S, e); } break;
        case 4: { Epi<4> e{d.ep}; pg8::gemm_phase(lds, d.g, S, e); } break;
        default: { Epi<5> e{d.ep}; pg8::gemm_phase(lds, d.g, S, e); } break;
    }
}

struct TcTile { const float* src; bf16_t* dst; const float* mu; int ld, col0, k0, ldd, n0, kd0, smode; };
DEV void tconv_load(const TcTile& t, int tid, f32x4 (&v)[2]) {
#pragma unroll
    for (int i = 0; i < 2; ++i) {
        const int kk = (tid >> 4) + 32 * i, c4 = (tid & 15) * 4;
        v[i] = *(const f32x4*)(t.src + (size_t)(t.k0 + kk) * t.ld + t.col0 + c4);
        float sc = 1.f; if (t.smode) { const float m = t.mu[t.k0 + kk]; sc = (t.smode == 1) ? (1.f - m) : m; }
        v[i] = v[i] * sc;
    }
}
DEV void tconv_put(float* tile, int tid, const f32x4 (&v)[2]) {
#pragma unroll
    for (int i = 0; i < 2; ++i) { const int kk = (tid >> 4) + 32 * i, c4 = (tid & 15) * 4;
        tile[kk * 65 + c4 + 0] = v[i][0]; tile[kk * 65 + c4 + 1] = v[i][1]; tile[kk * 65 + c4 + 2] = v[i][2]; tile[kk * 65 + c4 + 3] = v[i][3]; }
}
DEV void tconv_store(const float* tile, int tid, const TcTile& t) {
    const int nn = tid >> 3, kc = (tid & 7) * 8;
    u32x4 o; o.x = pk2(tile[(kc + 0) * 65 + nn], tile[(kc + 1) * 65 + nn]); o.y = pk2(tile[(kc + 2) * 65 + nn], tile[(kc + 3) * 65 + nn]);
    o.z = pk2(tile[(kc + 4) * 65 + nn], tile[(kc + 5) * 65 + nn]); o.w = pk2(tile[(kc + 6) * 65 + nn], tile[(kc + 7) * 65 + nn]);
    *(u32x4*)(t.dst + (size_t)(t.n0 + nn) * t.ldd + t.kd0 + kc) = o;
}
DEV void tconv_mat(const float* src, int ld, int K, int N, bf16_t* dst, int ldd, int kd0, int cmap, const float* mu, int smode, float* tile, int& base, int vb, int G) {
    const int nkb = K / 64, nt = nkb * (N / 64), tid = ltid();
    const int start = (int)((vb + G - (base % G)) % G);
    for (int t = start; t < nt; t += 2 * G) {
        const int t2 = t + G; const bool has2 = t2 < nt;
        TcTile a, b;
        { const int nb = t / nkb, kb = t % nkb; int col0 = nb * 64;
          if (cmap == 1) { const int pn = nb >> 2, bj = (nb >> 1) & 1, jb = nb & 1; col0 = bj * 2816 + pn * 128 + jb * 64; }
          a = TcTile{src, dst, mu, ld, col0, kb * 64, ldd, nb * 64, kd0 + kb * 64, smode}; }
        { const int tt = has2 ? t2 : t; const int nb = tt / nkb, kb = tt % nkb; int col0 = nb * 64;
          if (cmap == 1) { const int pn = nb >> 2, bj = (nb >> 1) & 1, jb = nb & 1; col0 = bj * 2816 + pn * 128 + jb * 64; }
          b = TcTile{src, dst, mu, ld, col0, kb * 64, ldd, nb * 64, kd0 + kb * 64, smode}; }
        f32x4 va[2], vb2[2];
        tconv_load(a, tid, va); if (has2) tconv_load(b, tid, vb2);
        tconv_put(tile, tid, va); if (has2) tconv_put(tile + 64 * 65, tid, vb2);
        __syncthreads();
        tconv_store(tile, tid, a); if (has2) tconv_store(tile + 64 * 65, tid, b);
        __syncthreads();
    }
    base += nt;
}
DEV void cvt_flat(const float* src, bf16_t* dst, size_t n8, int vb, int G) {
    const size_t stride = (size_t)G * NTHR; size_t i = (size_t)vb * NTHR + ltid();
    for (; i + 3 * stride < n8; i += 4 * stride) {
        f32x4 a[4], b[4];
#pragma unroll
        for (int u = 0; u < 4; ++u) { a[u] = *(const f32x4*)(src + (i + u * stride) * 8); b[u] = *(const f32x4*)(src + (i + u * stride) * 8 + 4); }
#pragma unroll
        for (int u = 0; u < 4; ++u) { u32x4 o; o.x = pk2(a[u][0], a[u][1]); o.y = pk2(a[u][2], a[u][3]); o.z = pk2(b[u][0], b[u][1]); o.w = pk2(b[u][2], b[u][3]);
            *(u32x4*)(dst + (i + u * stride) * 8) = o; }
    }
    for (; i < n8; i += stride) {
        const f32x4 a = *(const f32x4*)(src + i * 8), b = *(const f32x4*)(src + i * 8 + 4);
        u32x4 o; o.x = pk2(a[0], a[1]); o.y = pk2(a[2], a[3]); o.z = pk2(b[0], b[1]); o.w = pk2(b[2], b[3]);
        *(u32x4*)(dst + i * 8) = o;
    }
}
DEV void prep_phase(const KP& P, unsigned char* smem, int part, int vb, int G) {
    float* tile = (float*)smem; bf16_t* W = (bf16_t*)P.ws; int base = 0;
    bf16_t* VT = (bf16_t*)(P.ws + WS_VT); bf16_t* KB = (bf16_t*)(P.ws + WS_KB);
#define TC(...) tconv_mat(__VA_ARGS__, tile, base, vb, G)
    for (int i = 2 * part; i < 2 * part + 2; ++i) TC(PIN(12) + (size_t)i * 1024 * 5632, 5632, 1024, 5632, W + W_UP + (size_t)i * 5632 * 1024, 1024, 0, 1, nullptr, 0);
    for (int i = 2 * part; i < 2 * part + 2; ++i) TC(PIN(13) + (size_t)i * 2816 * 1024, 1024, 2816, 1024, W + W_DN + (size_t)i * 1024 * 2816, 2816, 0, 0, nullptr, 0);
    { const int l = part;
        TC(PIN(14) + (size_t)l * 1048576, 1024, 1024, 1024, W + W_XQ + (size_t)l * 1048576, 1024, 0, 0, nullptr, 0);
        TC(PIN(17) + (size_t)l * 1048576, 1024, 1024, 1024, W + W_XO + (size_t)l * 1048576, 1024, 0, 0, nullptr, 0); }
    if (part == 0) {
        for (int l = 0; l < 2; ++l) {
            TC(PIN(15) + (size_t)l * 1048576, 1024, 1024, 1024, W + W_KV + (size_t)l * 1048576, 1024, 0, 0, nullptr, 0);
            TC(PIN(16) + (size_t)l * 1048576, 1024, 1024, 1024, W + W_KV + (size_t)(2 + l) * 1048576, 1024, 0, 0, nullptr, 0); }
        TC(PIN(18), 3072, 1024, 3072, W + W_IN, 1024, 0, 0, nullptr, 0);
        TC(PIN(28), 1024, 1024, 1024, W + W_O0, 1024, 0, 0, nullptr, 0);
    } else {
        for (int p = 0; p < 3; ++p) {
            TC(PIN(30) + (size_t)p * 1048576, 1024, 1024, 1024, W + W_P1 + (size_t)p * 1024 * 2048, 2048, 0, 0, PIN(29) + p * 1024, 1);
            TC(PIN(30) + (size_t)p * 1048576, 1024, 1024, 1024, W + W_P1 + (size_t)p * 1024 * 2048, 2048, 1024, 0, PIN(29) + p * 1024, 2); }
        TC(PIN(32), 64, 1024, 64, W + W_P1 + (size_t)3072 * 2048, 2048, 0, 0, PIN(29) + 3 * 1024, 1);
        TC(PIN(32), 64, 1024, 64, W + W_P1 + (size_t)3072 * 2048, 2048, 1024, 0, PIN(29) + 3 * 1024, 2);
        TC(PIN(35), 64, 1024, 64, W + W_P1 + (size_t)3136 * 2048, 2048, 0, 0, PIN(29) + 4 * 1024, 1);
        TC(PIN(35), 64, 1024, 64, W + W_P1 + (size_t)3136 * 2048, 2048, 1024, 0, PIN(29) + 4 * 1024, 2);
        TC(PIN(37), 128, 1024, 128, W + W_P1 + (size_t)3200 * 2048, 2048, 0, 0, PIN(29) + 5 * 1024, 1);
        TC(PIN(37), 128, 1024, 128, W + W_P1 + (size_t)3200 * 2048, 2048, 1024, 0, PIN(29) + 5 * 1024, 2);
        TC(PIN(44), 1024, 1024, 1024, W + W_O1, 1024, 0, 0, nullptr, 0);
    }
    for (int j = 64 * part; j < 64 * part + 64; ++j) { const int l = j >> 6, b = (j >> 2) & 15, h = j & 3;
        TC(PIN(9) + (size_t)((l * 16 + b) * 256) * 1024 + h * 256, 1024, 256, 256, VT + (size_t)((l * 24 + 8 + b) * 4 + h) * 65536, 256, 0, 0, nullptr, 0); }
#undef TC
    { const int l = part; cvt_flat(PIN(8) + (size_t)l * 16 * 256 * 1024, KB + (size_t)(l * 24 + 8) * 256 * 1024, (size_t)16 * 256 * 1024 / 8, vb, G); }
    if (part == 0) {
        bf16_t* XB = (bf16_t*)(P.ws + WS_XB);
        cvt_flat(PIN(0), XB, (size_t)MPROMPT * 1024 / 8, vb, G);
        cvt_flat(PIN(1), XB + (size_t)MPROMPT * 1024, (size_t)512 * 1024 / 8, vb, G);
        cvt_flat(PIN(2), (bf16_t*)(P.ws + WS_A4), (size_t)2048 * 1024 / 8, vb, G);
    } else {
        for (int i = vb * NTHR + ltid(); i < 3072 * 32; i += G * NTHR) {
            const int n = i >> 5, kc = (i & 31) * 8; float v[8];
#pragma unroll
            for (int j = 0; j < 8; ++j) { const int k = kc + j; float x = 0.f;
                if (n < 1024) { if (k < 64) x = PIN(33)[(size_t)k * 1024 + n]; }
                else if (n < 2048) { if (k >= 64 && k < 128) x = PIN(36)[(size_t)(k - 64) * 1024 + (n - 1024)]; }
                else { if (k >= 128) x = PIN(38)[(size_t)(k - 128) * 1024 + (n - 2048)]; }
                v[j] = x; }
            *(u32x4*)(W + W_L2 + (size_t)n * 256 + kc) = pack8(v);
        }
    }
}

DEV void ln_phase(bf16_t* X, const float* g, const float* b, bf16_t* Xp, float* outf, const float* shift_in, float* outbase, bool dry) {
    const int lane = ltid() & 63, wave = ltid() >> 6;
    float gg[16], bb[16];
#pragma unroll
    for (int j = 0; j < 8; ++j) { gg[j] = g[lane * 8 + j]; gg[8 + j] = g[512 + lane * 8 + j]; bb[j] = b[lane * 8 + j]; bb[8 + j] = b[512 + lane * 8 + j]; }
    u32x4 na = (u32x4){0u, 0u, 0u, 0u}, nb = na;
    { const int r0 = blockIdx.x * 8 + wave; if (r0 < MTOK) { na = *(const u32x4*)(X + (size_t)r0 * 1024 + lane * 8); nb = *(const u32x4*)(X + (size_t)r0 * 1024 + 512 + lane * 8); } }
    for (int row = blockIdx.x * 8 + wave; row < MTOK; row += gridDim.x * 8) {
        bf16_t* xr = X + (size_t)row * 1024;
        float v[16]; unpack8(na, v); unpack8(nb, v + 8);
        { const int nr = row + gridDim.x * 8; if (nr < MTOK) { na = *(const u32x4*)(X + (size_t)nr * 1024 + lane * 8); nb = *(const u32x4*)(X + (size_t)nr * 1024 + 512 + lane * 8); } }
        float s = 0.f;
#pragma unroll
        for (int j = 0; j < 16; ++j) s += v[j];
        const float mean = wave_sum(s) * (1.f / 1024.f); float s2 = 0.f;
#pragma unroll
        for (int j = 0; j < 16; ++j) { v[j] -= mean; s2 += v[j] * v[j]; }
        const float rstd = rsqrtf(wave_sum(s2) * (1.f / 1024.f) + 1e-5f);
#pragma unroll
        for (int j = 0; j < 16; ++j) v[j] = v[j] * rstd * gg[j] + bb[j];
        const u32x4 o0 = pack8(v), o1 = pack8(v + 8);
        if (!dry) { *(u32x4*)(xr + lane * 8) = o0; *(u32x4*)(xr + 512 + lane * 8) = o1; }
        if (outf) { float* fo = outf + (size_t)row * 1024;
#pragma unroll
            for (int j = 0; j < 16; ++j) v[j] *= DBG_YSCALE;
            *(f32x4*)(fo + lane * 8) = (f32x4){v[0], v[1], v[2], v[3]}; *(f32x4*)(fo + lane * 8 + 4) = (f32x4){v[4], v[5], v[6], v[7]};
            *(f32x4*)(fo + 512 + lane * 8) = (f32x4){v[8], v[9], v[10], v[11]}; *(f32x4*)(fo + 512 + lane * 8 + 4) = (f32x4){v[12], v[13], v[14], v[15]}; }
        if (Xp) {
            int t, T, bidx; const bool prompt = row < MPROMPT;
            if (prompt) { bidx = row >> 12; t = row & 4095; T = 4096; } else { const int r2 = row - MPROMPT; bidx = r2 >> 5; t = r2 & 31; T = 32; }
            if (t + 1 < T) { bf16_t* xn = Xp + (size_t)(row + 1) * 1024; *(u32x4*)(xn + lane * 8) = o0; *(u32x4*)(xn + 512 + lane * 8) = o1; }
            else { float* so = outbase + (prompt ? O_PSHIFT : O_SSHIFT) + (size_t)bidx * 1024;
#pragma unroll
                for (int j = 0; j < 16; ++j) v[j] *= DBG_SHSCALE;
                *(f32x4*)(so + lane * 8) = (f32x4){v[0], v[1], v[2], v[3]}; *(f32x4*)(so + lane * 8 + 4) = (f32x4){v[4], v[5], v[6], v[7]};
                *(f32x4*)(so + 512 + lane * 8) = (f32x4){v[8], v[9], v[10], v[11]}; *(f32x4*)(so + 512 + lane * 8 + 4) = (f32x4){v[12], v[13], v[14], v[15]}; }
            if (t == 0) { bf16_t* x0 = Xp + (size_t)row * 1024; float z[16];
#pragma unroll
                for (int j = 0; j < 8; ++j) { z[j] = prompt ? 0.f : shift_in[(size_t)bidx * 1024 + lane * 8 + j]; z[8 + j] = prompt ? 0.f : shift_in[(size_t)bidx * 1024 + 512 + lane * 8 + j]; }
                *(u32x4*)(x0 + lane * 8) = pack8(z); *(u32x4*)(x0 + 512 + lane * 8) = pack8(z + 8); }
        }
    }
}

DEV void attn_phase(const bf16_t* Q, const bf16_t* KBl, const bf16_t* VTl, bf16_t* AO, unsigned char* smem) {
    const int tid = ltid(), lane = tid & 63, wave = tid >> 6, fr = lane & 15, g = lane >> 4;
    bf16_t* Ks = (bf16_t*)smem;
    bf16_t* Vs = (bf16_t*)(smem + 64 * 264 * 2);
    for (int job = blockIdx.x; job < 1088; job += gridDim.x) {
        int s, h, row0, nvalid;
        if (job < 1024) { s = job >> 7; h = (job >> 5) & 3; row0 = s * 4096 + (job & 31) * 128; nvalid = 128; }
        else { const int j2 = job - 1024; s = 8 + (j2 >> 2); h = j2 & 3; row0 = MPROMPT + (s - 8) * 32; nvalid = 32; }
        const int myrow = wave * 16 + fr; const bool valid = myrow < nvalid;
        const bf16_t* qp = Q + (size_t)(row0 + (valid ? myrow : 0)) * 1024 + h * 256 + g * 8;
        bf16x8 qf[8];
#pragma unroll
        for (int s8 = 0; s8 < 8; ++s8) qf[s8] = *(const bf16x8*)(qp + s8 * 32);
        f32x4 sc[16];
#pragma unroll
        for (int i = 0; i < 16; ++i) sc[i] = (f32x4){0.f, 0.f, 0.f, 0.f};
        const bf16_t* Kg = KBl + (size_t)s * 256 * 1024 + h * 256;
        const bf16_t* Vg = VTl + (size_t)(s * 4 + h) * 65536;
        u32x4 pre[4];
#pragma unroll
        for (int i = 0; i < 4; ++i) { const int ch = tid + i * 512, key = ch >> 5, dc = (ch & 31) * 8; pre[i] = *(const u32x4*)(Kg + (size_t)key * 1024 + dc); }
#pragma unroll
        for (int kt4 = 0; kt4 < 4; ++kt4) {
            __syncthreads();
#pragma unroll
            for (int i = 0; i < 4; ++i) { const int ch = tid + i * 512, key = ch >> 5, dc = (ch & 31) * 8; *(u32x4*)(Ks + key * 264 + dc) = pre[i]; }
            __syncthreads();
            if (kt4 < 3) {
#pragma unroll
                for (int i = 0; i < 4; ++i) { const int ch = tid + i * 512, key = ch >> 5, dc = (ch & 31) * 8; pre[i] = *(const u32x4*)(Kg + (size_t)((kt4 + 1) * 64 + key) * 1024 + dc); }
            } else {
#pragma unroll
                for (int i = 0; i < 4; ++i) { const int ch = tid + i * 512, d = ch >> 3, kc = (ch & 7) * 8; pre[i] = *(const u32x4*)(Vg + (size_t)d * 256 + kc); }
            }
#pragma unroll
            for (int kt = 0; kt < 4; ++kt)
#pragma unroll
                for (int s8 = 0; s8 < 8; ++s8) { const bf16x8 kf = *(const bf16x8*)(Ks + (kt * 16 + fr) * 264 + s8 * 32 + g * 8);
                    sc[kt4 * 4 + kt] = mfma16(kf, qf[s8], sc[kt4 * 4 + kt]); }
        }
        float mx = -3.0e38f;
#pragma unroll
        for (int i = 0; i < 16; ++i)
#pragma unroll
            for (int r = 0; r < 4; ++r) mx = fmaxf(mx, sc[i][r]);
        mx = fmaxf(mx, __shfl_xor(mx, 16)); mx = fmaxf(mx, __shfl_xor(mx, 32));
        float sum = 0.f;
#pragma unroll
        for (int i = 0; i < 16; ++i)
#pragma unroll
            for (int r = 0; r < 4; ++r) { const float pv = exp2f((sc[i][r] - mx) * (0.0625f * 1.44269504f)); sc[i][r] = pv; sum += pv; }
        sum += __shfl_xor(sum, 16); sum += __shfl_xor(sum, 32);
        bf16x8 pf[8];
#pragma unroll
        for (int s2 = 0; s2 < 8; ++s2) { u32x4 o; o.x = pk2(sc[2 * s2][0], sc[2 * s2][1]); o.y = pk2(sc[2 * s2][2], sc[2 * s2][3]);
            o.z = pk2(sc[2 * s2 + 1][0], sc[2 * s2 + 1][1]); o.w = pk2(sc[2 * s2 + 1][2], sc[2 * s2 + 1][3]); pf[s2] = __builtin_bit_cast(bf16x8, o); }
        f32x4 oa[16];
#pragma unroll
        for (int i = 0; i < 16; ++i) oa[i] = (f32x4){0.f, 0.f, 0.f, 0.f};
#pragma unroll
        for (int vt4 = 0; vt4 < 4; ++vt4) {
            __syncthreads();
#pragma unroll
            for (int i = 0; i < 4; ++i) { const int ch = tid + i * 512, d = ch >> 3, kc = (ch & 7) * 8; *(u32x4*)(Vs + d * 72 + kc) = pre[i]; }
            __syncthreads();
            if (vt4 < 3) {
#pragma unroll
                for (int i = 0; i < 4; ++i) { const int ch = tid + i * 512, d = ch >> 3, kc = (ch & 7) * 8; pre[i] = *(const u32x4*)(Vg + (size_t)d * 256 + (vt4 + 1) * 64 + kc); }
            }
#pragma unroll
            for (int s2l = 0; s2l < 2; ++s2l)
#pragma unroll
                for (int dt = 0; dt < 16; ++dt) {
                    const bf16_t* vp = Vs + (dt * 16 + fr) * 72 + 32 * s2l + 4 * g;
                    const u32x2 lo = *(const u32x2*)vp, hi = *(const u32x2*)(vp + 16);
                    u32x4 c; c.x = lo.x; c.y = lo.y; c.z = hi.x; c.w = hi.y;
                    oa[dt] = mfma16(__builtin_bit_cast(bf16x8, c), pf[vt4 * 2 + s2l], oa[dt]);
                }
        }
        const float inv = 1.f / sum;
        if (valid) { bf16_t* op = AO + (size_t)(row0 + myrow) * 1024 + h * 256 + 4 * g;
#pragma unroll
            for (int dt = 0; dt < 16; ++dt) { u32x2 o; o.x = pk2(oa[dt][0] * inv, oa[dt][1] * inv); o.y = pk2(oa[dt][2] * inv, oa[dt][3] * inv); *(u32x2*)(op + dt * 16) = o; } }
    }
}

DEV void ret_job(int s, int h, const KP& P, const bf16_t* PB, bf16_t* YM, unsigned char* smem) {
    const int tid = ltid(), lane = tid & 63, w = tid >> 6, fr = lane & 15, g = lane >> 4;
    const bool prompt = s < 8; const int T = prompt ? 4096 : 32, C = prompt ? DBG_C_RET : 32, nch = T / C;
    const int row0 = prompt ? s * 4096 : MPROMPT + (s - 8) * 32, pos0 = prompt ? 0 : 4096;
    const float log2g = log2f(1.f - exp2f(-5.f - (float)h));
    const float cdecay = exp2f(log2g * (float)C);
    bf16_t* Qs = (bf16_t*)smem;
    bf16_t* Ks = (bf16_t*)(smem + 17408);
    bf16_t* Kt = (bf16_t*)(smem + 34816);
    bf16_t* Vt = (bf16_t*)(smem + 53248);
    bf16_t* St = (bf16_t*)(smem + 71680);
    bf16_t* Ps = (bf16_t*)(smem + 106496);
    float* Os = (float*)smem;
    const float* st_in = prompt ? nullptr : PIN(5) + (size_t)((s - 8) * 4 + h) * 16384;
    float* st_out = P.out + (prompt ? O_PRET + (size_t)(s * 4 + h) * 16384 : O_SRET + (size_t)((s - 8) * 4 + h) * 16384);
    f32x4 Sacc[8];
#pragma unroll
    for (int dvt = 0; dvt < 8; ++dvt)
#pragma unroll
        for (int r = 0; r < 4; ++r) Sacc[dvt][r] = st_in ? st_in[(size_t)(16 * w + 4 * g + r) * 128 + dvt * 16 + fr] : 0.f;
    __syncthreads();
    for (int i = tid; i < 71680 / 16; i += NTHR) ((u32x4*)smem)[i] = (u32x4){0u, 0u, 0u, 0u};
#pragma unroll
    for (int dvt = 0; dvt < 8; ++dvt) { u32x2 o; o.x = pk2(Sacc[dvt][0], Sacc[dvt][1]); o.y = pk2(Sacc[dvt][2], Sacc[dvt][3]);
        *(u32x2*)(St + (dvt * 16 + fr) * 136 + 16 * w + 4 * g) = o; }
    __syncthreads();
    const float* gng = PIN(26) + h * 128; const float* gnb = PIN(27) + h * 128;
    u32x4 pq1 = (u32x4){0u, 0u, 0u, 0u}, pq2 = pq1, pk1 = pq1, pk2r = pq1, pv0 = pq1, pv1 = pq1, pg0 = pq1, pg1 = pq1;
#define RET_LOAD(ch_) do { const bf16_t* bp_ = PB + (size_t)(row0 + (ch_) * C + (tid >> 3)) * 3072 + h * 128; const int sg_ = tid & 7; \
        pq1 = *(const u32x4*)(bp_ + 1024 + sg_ * 8); pq2 = *(const u32x4*)(bp_ + 1024 + 64 + sg_ * 8); pk1 = *(const u32x4*)(bp_ + 1536 + sg_ * 8); pk2r = *(const u32x4*)(bp_ + 1536 + 64 + sg_ * 8); \
        pv0 = *(const u32x4*)(bp_ + 2048 + sg_ * 16); pv1 = *(const u32x4*)(bp_ + 2048 + sg_ * 16 + 8); } while (0)
    if ((tid >> 3) < C) RET_LOAD(0);
    for (int ch = 0; ch < nch; ++ch) {
        {
            const int t = tid >> 3, seg = tid & 7;
            if (t < C) {
                float q1[8], q2[8], k1[8], k2[8];
                unpack8(pq1, q1); unpack8(pq2, q2); unpack8(pk1, k1); unpack8(pk2r, k2);
                const u32x4 v0 = pv0, v1 = pv1;
                const float pos = (float)(pos0 + ch * C + t);
                const float zeta = exp2f(log2g * (float)(C - 1 - t));
                float qa[8], qb[8], ka[8], kb[8];
#pragma unroll
                for (int j = 0; j < 8; ++j) {
                    const int d = seg * 8 + j;
                    const float invf = exp2f(-(float)d * (13.287712379549449f / 64.f));
                    const float rev = pos * invf * 0.15915494309189535f; const float frc = rev - floorf(rev);
                    const float sn = __builtin_amdgcn_sinf(frc), cs = __builtin_amdgcn_cosf(frc);
                    qa[j] = q1[j] * cs - q2[j] * sn; qb[j] = q1[j] * sn + q2[j] * cs;
                    ka[j] = (k1[j] * cs - k2[j] * sn) * 0.08838834764831845f; kb[j] = (k1[j] * sn + k2[j] * cs) * 0.08838834764831845f;
                    Kt[d * 72 + t] = f2bf(ka[j] * zeta); Kt[(64 + d) * 72 + t] = f2bf(kb[j] * zeta);
                }
                *(u32x4*)(Qs + t * 136 + seg * 8) = pack8(qa); *(u32x4*)(Qs + t * 136 + 64 + seg * 8) = pack8(qb);
                *(u32x4*)(Ks + t * 136 + seg * 8) = pack8(ka); *(u32x4*)(Ks + t * 136 + 64 + seg * 8) = pack8(kb);
                const unsigned vv[8] = {v0.x, v0.y, v0.z, v0.w, v1.x, v1.y, v1.z, v1.w};
#pragma unroll
                for (int j = 0; j < 8; ++j) { Vt[(seg * 16 + 2 * j) * 72 + t] = (bf16_t)(vv[j] & 0xffffu); Vt[(seg * 16 + 2 * j + 1) * 72 + t] = (bf16_t)(vv[j] >> 16); }
                { const bf16_t* gp_ = PB + (size_t)(row0 + ch * C + t) * 3072 + 2560 + h * 128 + seg * 16; pg0 = *(const u32x4*)gp_; pg1 = *(const u32x4*)(gp_ + 8); }
                if (ch + 1 < nch) RET_LOAD(ch + 1);
            }
        }
        __syncthreads();
        {
            const int jt = w & 3;
#pragma unroll
            for (int x = 0; x < 2; ++x) {
                const int it = 2 * (w >> 2) + x; f32x4 a = (f32x4){0.f, 0.f, 0.f, 0.f};
#pragma unroll
                for (int s4 = 0; s4 < 4; ++s4) a = mfma16(*(const bf16x8*)(Ks + (jt * 16 + fr) * 136 + s4 * 32 + g * 8), *(const bf16x8*)(Qs + (it * 16 + fr) * 136 + s4 * 32 + g * 8), a);
                const int i = it * 16 + fr; float pr[4];
#pragma unroll
                for (int r = 0; r < 4; ++r) { const int j = jt * 16 + 4 * g + r; pr[r] = (i >= j) ? a[r] * exp2f(log2g * (float)(i - j)) : 0.f; }
                u32x2 o; o.x = pk2(pr[0], pr[1]); o.y = pk2(pr[2], pr[3]);
                *(u32x2*)(Ps + i * 72 + jt * 16 + 4 * g) = o;
            }
        }
        __syncthreads();
        f32x4 oacc[4];
        {
            const int it = w & 3;
#pragma unroll
            for (int x = 0; x < 4; ++x) {
                const int dvt = 4 * (w >> 2) + x; f32x4 a = (f32x4){0.f, 0.f, 0.f, 0.f};
#pragma unroll
                for (int s4 = 0; s4 < 4; ++s4) a = mfma16(*(const bf16x8*)(Qs + (it * 16 + fr) * 136 + s4 * 32 + g * 8), *(const bf16x8*)(St + (dvt * 16 + fr) * 136 + s4 * 32 + g * 8), a);
#pragma unroll
                for (int r = 0; r < 4; ++r) a[r] *= exp2f(log2g * (float)(it * 16 + 4 * g + r + 1));
#pragma unroll
                for (int s2 = 0; s2 < 2; ++s2) a = mfma16(*(const bf16x8*)(Ps + (it * 16 + fr) * 72 + s2 * 32 + g * 8), *(const bf16x8*)(Vt + (dvt * 16 + fr) * 72 + s2 * 32 + g * 8), a);
                oacc[x] = a;
            }
#pragma unroll
            for (int dvt = 0; dvt < 8; ++dvt) {
                f32x4 a = Sacc[dvt] * cdecay;
#pragma unroll
                for (int s2 = 0; s2 < 2; ++s2) a = mfma16(*(const bf16x8*)(Kt + (16 * w + fr) * 72 + s2 * 32 + g * 8), *(const bf16x8*)(Vt + (dvt * 16 + fr) * 72 + s2 * 32 + g * 8), a);
                Sacc[dvt] = a;
            }
        }
        __syncthreads();
        {
            const int it = w & 3;
#pragma unroll
            for (int x = 0; x < 4; ++x) { const int dvt = 4 * (w >> 2) + x;
#pragma unroll
                for (int r = 0; r < 4; ++r) Os[(it * 16 + 4 * g + r) * 132 + dvt * 16 + fr] = oacc[x][r]; }
#pragma unroll
            for (int dvt = 0; dvt < 8; ++dvt) { u32x2 o; o.x = pk2(Sacc[dvt][0], Sacc[dvt][1]); o.y = pk2(Sacc[dvt][2], Sacc[dvt][3]);
                *(u32x2*)(St + (dvt * 16 + fr) * 136 + 16 * w + 4 * g) = o; }
        }
        __syncthreads();
        {
            const int i = tid >> 3, seg = tid & 7; float o[16]; float sm = 0.f;
#pragma unroll
            for (int j = 0; j < 16; ++j) { o[j] = Os[i * 132 + seg * 16 + j]; sm += o[j]; }
            const float mean = red8(sm) * (1.f / 128.f); float s2 = 0.f;
#pragma unroll
            for (int j = 0; j < 16; ++j) { o[j] -= mean; s2 += o[j] * o[j]; }
            const float rstd = rsqrtf(red8(s2) * (1.f / 128.f) + 1e-5f);
            if (i < C) {
                const size_t row = (size_t)(row0 + ch * C + i);
                float gt[16]; unpack8(pg0, gt); unpack8(pg1, gt + 8);
#pragma unroll
                for (int j = 0; j < 16; ++j) { const float y = o[j] * rstd * gng[seg * 16 + j] + gnb[seg * 16 + j]; o[j] = y * gt[j] * sigmoidf_(gt[j]); }
                *(u32x4*)(YM + row * 1024 + 512 + h * 128 + seg * 16) = pack8(o); *(u32x4*)(YM + row * 1024 + 512 + h * 128 + seg * 16 + 8) = pack8(o + 8);
            }
        }
        __syncthreads();
    }
#pragma unroll
    for (int dvt = 0; dvt < 8; ++dvt)
#pragma unroll
        for (int r = 0; r < 4; ++r) st_out[(size_t)(16 * w + 4 * g + r) * 128 + dvt * 16 + fr] = Sacc[dvt][r] * DBG_RETSCALE;
}

DEV void lru_job(int s, int gb, const KP& P, const bf16_t* PB, bf16_t* YM, unsigned char* smem) {
    const int tid = ltid(), lane = tid & 63, w = tid >> 6, fr = lane & 15, g = lane >> 4;
    const bool prompt = s < 8; const int T = prompt ? 4096 : 32, C = prompt ? DBG_C : 32, nch = T / C;
    const int row0 = prompt ? s * 4096 : MPROMPT + (s - 8) * 32, bidx = prompt ? s : s - 8;
    bf16_t* Wt = (bf16_t*)smem;
    bf16_t* Xc = (bf16_t*)(smem + 18432);
    float* Xr = (float*)(smem + 27648);
    float* GA = (float*)(smem + 44800);
    float* GI = (float*)(smem + 61440);
    __syncthreads();
    for (int i = tid; i < 128 * 64; i += NTHR) { const int co = i >> 6, ci = i & 63;
        const float* wsrc = (co < 64) ? PIN(21) : PIN(23);
        Wt[co * 72 + ci] = f2bf(wsrc[(size_t)gb * 4096 + ci * 64 + (co & 63)]); }
    for (int i = tid; i < 64 * 72 / 2; i += NTHR) ((unsigned*)Xc)[i] = 0u;
    if (tid < 192) { const int j = tid >> 6, c = tid & 63; Xr[j * 64 + c] = prompt ? 0.f : PIN(3)[(size_t)(bidx * 3 + j) * 512 + gb * 64 + c]; }
    const int t = tid >> 3, seg = tid & 7, c0 = gb * 64 + seg * 8;
    float cw[4][8], cb[8], spl[8];
#pragma unroll
    for (int j = 0; j < 8; ++j) { cb[j] = PIN(20)[c0 + j]; const float lam = PIN(25)[c0 + j]; spl[j] = -8.f * log1pf(__expf(-lam));
#pragma unroll
        for (int q = 0; q < 4; ++q) cw[q][j] = PIN(19)[q * 512 + c0 + j]; }
    float* SUMS = (float*)(smem + 78080);
    float* HC = (float*)(smem + 82176);
    if (tid < 64) HC[tid] = prompt ? 0.f : PIN(4)[(size_t)bidx * 512 + gb * 64 + tid];
    const float* bias_g = (w < 4) ? PIN(22) : PIN(24);
    __syncthreads();
    u32x4 px = (u32x4){0u, 0u, 0u, 0u}, pga = px;
    if (t < C) px = *(const u32x4*)(PB + (size_t)(row0 + t) * 3072 + c0);
    for (int ch = 0; ch < nch; ++ch) {
        if (t < C) { float x[8]; unpack8(px, x);
#pragma unroll
            for (int j = 0; j < 8; ++j) Xr[(3 + t) * 64 + seg * 8 + j] = x[j];
            pga = *(const u32x4*)(PB + (size_t)(row0 + ch * C + t) * 3072 + 512 + c0);
            if (ch + 1 < nch) px = *(const u32x4*)(PB + (size_t)(row0 + (ch + 1) * C + t) * 3072 + c0); }
        __syncthreads();
        float xc[8];
#pragma unroll
        for (int j = 0; j < 8; ++j) xc[j] = 0.f;
        if (t < C) {
#pragma unroll
            for (int j = 0; j < 8; ++j) { float a = cb[j];
#pragma unroll
                for (int q = 0; q < 4; ++q) a += cw[q][j] * Xr[(t + q) * 64 + seg * 8 + j];
                xc[j] = a; }
            *(u32x4*)(Xc + t * 72 + seg * 8) = pack8(xc);
        }
        __syncthreads();
        {
            const int tt = w & 3;
#pragma unroll
            for (int x = 0; x < 4; ++x) { const int cot = 4 * (w >> 2) + x; f32x4 a = (f32x4){0.f, 0.f, 0.f, 0.f};
#pragma unroll
                for (int s2 = 0; s2 < 2; ++s2) a = mfma16(*(const bf16x8*)(Xc + (tt * 16 + fr) * 72 + s2 * 32 + g * 8), *(const bf16x8*)(Wt + (cot * 16 + fr) * 72 + s2 * 32 + g * 8), a);
                const int co = (cot & 3) * 16 + fr; const float bs = bias_g[gb * 64 + co]; float* dst = (w < 4) ? GA : GI;
#pragma unroll
                for (int r = 0; r < 4; ++r) dst[(tt * 16 + 4 * g + r) * 65 + co] = sigmoidf_(a[r] + bs); }
        }
        __syncthreads();
        if (t < C) {
#pragma unroll
            for (int j = 0; j < 8; ++j) { const int c = seg * 8 + j; const float rg = GA[t * 65 + c], ig = GI[t * 65 + c];
                const float la = spl[j] * rg, a = __expf(la); const float mult = sqrtf(fmaxf(1.f - a * a, 0.f));
                GA[t * 65 + c] = a; GI[t * 65 + c] = mult * (ig * xc[j]); }
        }
        __syncthreads();
        {
            const int SEG = C >> 3, wu = __builtin_amdgcn_readfirstlane(w);
            float pl[8], hl[8]; float pp = 1.f, hh = 0.f;
#pragma unroll
            for (int j = 0; j < 8; ++j) if (j < SEG) { const int tt = wu * SEG + j; const float a_ = GA[tt * 65 + lane], u_ = GI[tt * 65 + lane]; hh = a_ * hh + u_; pp *= a_; hl[j] = hh; pl[j] = pp; }
            SUMS[(wu * 64 + lane) * 2] = pp; SUMS[(wu * 64 + lane) * 2 + 1] = hh;
            if (wu == 1) { const float r0 = Xr[(C + 0) * 64 + lane], r1 = Xr[(C + 1) * 64 + lane], r2 = Xr[(C + 2) * 64 + lane];
                Xr[lane] = r0; Xr[64 + lane] = r1; Xr[128 + lane] = r2; }
            __syncthreads();
            float carry = HC[lane];
            for (int w2 = 0; w2 < wu; ++w2) carry = SUMS[(w2 * 64 + lane) * 2] * carry + SUMS[(w2 * 64 + lane) * 2 + 1];
#pragma unroll
            for (int j = 0; j < 8; ++j) if (j < SEG) GI[(wu * SEG + j) * 65 + lane] = hl[j] + pl[j] * carry;
            const float ncar = pp * carry + hh;
            __syncthreads();
            if (wu == 7) HC[lane] = ncar;
        }
        if (t < C) { const size_t row = (size_t)(row0 + ch * C + t); float ga[8]; unpack8(pga, ga); float y[8];
#pragma unroll
            for (int j = 0; j < 8; ++j) { const float x = ga[j]; const float ge = 0.5f * x * (1.f + tanhf_(0.7978845608f * (x + 0.044715f * x * x * x))); y[j] = GI[t * 65 + seg * 8 + j] * ge; }
            *(u32x4*)(YM + row * 1024 + c0) = pack8(y); }
        __syncthreads();
    }
    if (tid < 64) P.out[(prompt ? O_PLRU : O_SLRU) + (size_t)bidx * 512 + gb * 64 + tid] = HC[tid] * DBG_LRUSCALE;
    if (tid < 192) { const int j = tid >> 6, c = tid & 63; P.out[(prompt ? O_PCONV : O_SCONV) + (size_t)(bidx * 3 + j) * 512 + gb * 64 + c] = Xr[j * 64 + c] * DBG_CONVSCALE; }
    __syncthreads();
}

DEV void wkv_job(int s, int h, const KP& P, bf16_t* RO, const bf16_t* Kk, const bf16_t* Vv, const bf16_t* Ee, const bf16_t* Aa, const bf16_t* Gg, unsigned char* smem, bool dry) {
    const int tid = ltid(), q = tid & 15, rp = tid >> 4;
    const bool prompt = s < 8; const int T = prompt ? 4096 : 32, nch = T / 32;
    const int row0 = prompt ? s * 4096 : MPROMPT + (s - 8) * 32, bidx = prompt ? s : s - 8;
    float* vec = (float*)smem;
    float* vvb = (float*)(smem + 81920);
    float* rkb = (float*)(smem + 98304);
    float* ob = (float*)(smem + 98560);
    const float* sin_ = prompt ? nullptr : PIN(7) + (size_t)(bidx * 16 + h) * 4096;
    float* sout = P.out + (prompt ? O_PWKV : O_SWKV) + (size_t)(bidx * 16 + h) * 4096;
    const int cc = h * 64 + 4 * q;
    f32x4 S0 = (f32x4){0.f, 0.f, 0.f, 0.f}, S1 = S0;
    if (sin_) { S0 = *(const f32x4*)(sin_ + rp * 64 + 4 * q); S1 = *(const f32x4*)(sin_ + (rp + 32) * 64 + 4 * q); }
    const f32x4 kkw = *(const f32x4*)(PIN(39) + cc), kaw = *(const f32x4*)(PIN(40) + cc), rkw = *(const f32x4*)(PIN(41) + cc);
    const f32x4 gng = *(const f32x4*)(PIN(42) + cc), gnb = *(const f32x4*)(PIN(43) + cc);
    u32x2 rr, rk_, rv, re, ra, rg;
#define WKV_LOAD(c_) do { const size_t o_ = (size_t)(row0 + (c_) * 32 + rp) * 1024 + cc; rr = *(const u32x2*)(RO + o_); rk_ = *(const u32x2*)(Kk + o_); \
        rv = *(const u32x2*)(Vv + o_); re = *(const u32x2*)(Ee + o_); ra = *(const u32x2*)(Aa + o_); } while (0)
#define WKV_DERIVE(buf_) do { \
        const f32x4 rf = (f32x4){bflo(rr.x), bfhi(rr.x), bflo(rr.y), bfhi(rr.y)}, kf = (f32x4){bflo(rk_.x), bfhi(rk_.x), bflo(rk_.y), bfhi(rk_.y)}; \
        const f32x4 vf = (f32x4){bflo(rv.x), bfhi(rv.x), bflo(rv.y), bfhi(rv.y)}, ef = (f32x4){bflo(re.x), bfhi(re.x), bflo(re.y), bfhi(re.y)}; \
        const f32x4 af = (f32x4){bflo(ra.x), bfhi(ra.x), bflo(ra.y), bfhi(ra.y)}; \
        f32x4 kkv = kf * kkw; const float ss = red16(kkv[0] * kkv[0] + kkv[1] * kkv[1] + kkv[2] * kkv[2] + kkv[3] * kkv[3]); \
        const float inv = 1.f / fmaxf(sqrtf(ss), 1e-12f); kkv = kkv * inv; \
        const f32x4 km = kf * (1.f + (af - 1.f) * kaw); \
        f32x4 wv; wv[0] = __expf(-ef[0]); wv[1] = __expf(-ef[1]); wv[2] = __expf(-ef[2]); wv[3] = __expf(-ef[3]); \
        const f32x4 t3 = rf * km * rkw; const float rks = red16(t3[0] + t3[1] + t3[2] + t3[3]); \
        float* vb_ = vec + ((buf_) * 32 + rp) * 320 + 4 * q; \
        *(f32x4*)(vb_) = -kkv; *(f32x4*)(vb_ + 64) = wv; *(f32x4*)(vb_ + 128) = kkv * af; *(f32x4*)(vb_ + 192) = km; *(f32x4*)(vb_ + 256) = rf; \
        *(f32x4*)(vvb + ((buf_) * 32 + rp) * 64 + 4 * q) = vf; if (q == 0) rkb[(buf_) * 32 + rp] = rks; } while (0)
    __syncthreads();
    WKV_LOAD(0); WKV_DERIVE(0);
    __syncthreads();
    for (int c = 0; c < nch; ++c) {
        const int buf = c & 1;
        if (c + 1 < nch) WKV_LOAD(c + 1);
        rg = *(const u32x2*)(Gg + (size_t)(row0 + c * 32 + rp) * 1024 + cc);
        const float* vb = vec + buf * 32 * 320 + 4 * q; const float* vvp = vvb + buf * 32 * 64;
        f32x4 n4 = *(const f32x4*)(vb), w4 = *(const f32x4*)(vb + 64), b4 = *(const f32x4*)(vb + 128), k4 = *(const f32x4*)(vb + 192), r4 = *(const f32x4*)(vb + 256);
        float v0 = vvp[rp], v1 = vvp[rp + 32];
#pragma unroll 4
        for (int t = 0; t < 32; ++t) {
            const int tn = (t + 1) & 31;
            const f32x4 n4n = *(const f32x4*)(vb + tn * 320), w4n = *(const f32x4*)(vb + tn * 320 + 64), b4n = *(const f32x4*)(vb + tn * 320 + 128),
                        k4n = *(const f32x4*)(vb + tn * 320 + 192), r4n = *(const f32x4*)(vb + tn * 320 + 256);
            const float v0n = vvp[tn * 64 + rp], v1n = vvp[tn * 64 + rp + 32];
            const float sa0 = red16(S0[0] * n4[0] + S0[1] * n4[1] + S0[2] * n4[2] + S0[3] * n4[3]);
            const float sa1 = red16(S1[0] * n4[0] + S1[1] * n4[1] + S1[2] * n4[2] + S1[3] * n4[3]);
            S0 = S0 * w4 + (b4 * sa0 + k4 * v0);
            S1 = S1 * w4 + (b4 * sa1 + k4 * v1);
            const float o0 = red16(S0[0] * r4[0] + S0[1] * r4[1] + S0[2] * r4[2] + S0[3] * r4[3]);
            const float o1 = red16(S1[0] * r4[0] + S1[1] * r4[1] + S1[2] * r4[2] + S1[3] * r4[3]);
            if (q == 0) { ob[t * 64 + rp] = o0; ob[t * 64 + rp + 32] = o1; }
            n4 = n4n; w4 = w4n; b4 = b4n; k4 = k4n; r4 = r4n; v0 = v0n; v1 = v1n;
        }
        __syncthreads();
        {
            f32x4 o = *(const f32x4*)(ob + rp * 64 + 4 * q);
            const float mean = red16(o[0] + o[1] + o[2] + o[3]) * (1.f / 64.f); o = o - mean;
            const float var = red16(o[0] * o[0] + o[1] * o[1] + o[2] * o[2] + o[3] * o[3]) * (1.f / 64.f);
            const float rstd = rsqrtf(var + 64e-5f);
            const f32x4 vf = *(const f32x4*)(vvp + rp * 64 + 4 * q); const float rks = rkb[buf * 32 + rp];
            const f32x4 gf = (f32x4){bflo(rg.x), bfhi(rg.x), bflo(rg.y), bfhi(rg.y)};
            const f32x4 y = (o * rstd * gng + gnb + vf * rks) * gf;
            u32x2 st; st.x = pk2(y[0], y[1]); st.y = pk2(y[2], y[3]);
            if (!dry) *(u32x2*)(RO + (size_t)(row0 + c * 32 + rp) * 1024 + cc) = st;
        }
        if (c + 1 < nch) WKV_DERIVE(buf ^ 1);
        __syncthreads();
    }
    *(f32x4*)(sout + rp * 64 + 4 * q) = S0 * DBG_WKVSCALE; *(f32x4*)(sout + (rp + 32) * 64 + 4 * q) = S1 * DBG_WKVSCALE;
#undef WKV_LOAD
#undef WKV_DERIVE
}


DEV void wkv_half(int s, int h, int half, const KP& P, bf16_t* RO, const bf16_t* Kk, const bf16_t* Vv, const bf16_t* Ee, const bf16_t* Aa, const bf16_t* Gg, unsigned long long* xch, unsigned char* smem) {
    const int tid = ltid(), q = tid & 15, rp = tid >> 4;
    const bool prompt = s < 8; const int T = prompt ? 4096 : 32, nch = T / 32;
    const int row0 = prompt ? s * 4096 : MPROMPT + (s - 8) * 32, bidx = prompt ? s : s - 8;
    float* vec = (float*)smem;
    float* vvb = (float*)(smem + 81920);
    float* rkb = (float*)(smem + 98304);
    float* ob = (float*)(smem + 98560);
    float* statb = (float*)(smem + 106752);
    const int crow = half * 32;
    const float* sin_ = prompt ? nullptr : PIN(7) + (size_t)(bidx * 16 + h) * 4096;
    float* sout = P.out + (prompt ? O_PWKV : O_SWKV) + (size_t)(bidx * 16 + h) * 4096;
    const size_t gbase = prompt ? (size_t)(s * 16 + h) * 4096 : (size_t)128 * 4096 + (size_t)((s - 8) * 16 + h) * 32;
    const int cc = h * 64 + 4 * q, c2 = h * 64 + crow + 2 * q;
    f32x4 S0 = (f32x4){0.f, 0.f, 0.f, 0.f};
    if (sin_) S0 = *(const f32x4*)(sin_ + (crow + rp) * 64 + 4 * q);
    const f32x4 kkw = *(const f32x4*)(PIN(39) + cc), kaw = *(const f32x4*)(PIN(40) + cc), rkw = *(const f32x4*)(PIN(41) + cc);
    const float gw0 = PIN(42)[c2], gw1 = PIN(42)[c2 + 1], gb0 = PIN(43)[c2], gb1 = PIN(43)[c2 + 1];
    u32x2 rr, rk_, rv, re, ra; unsigned rgp = 0u;
#define WKV_LOAD(c_) do { const size_t o_ = (size_t)(row0 + (c_) * 32 + rp) * 1024 + cc; rr = *(const u32x2*)(RO + o_); rk_ = *(const u32x2*)(Kk + o_); \
        rv = *(const u32x2*)(Vv + o_); re = *(const u32x2*)(Ee + o_); ra = *(const u32x2*)(Aa + o_); } while (0)
#define WKV_DERIVE(buf_) do { \
        const f32x4 rf = (f32x4){bflo(rr.x), bfhi(rr.x), bflo(rr.y), bfhi(rr.y)}, kf = (f32x4){bflo(rk_.x), bfhi(rk_.x), bflo(rk_.y), bfhi(rk_.y)}; \
        const f32x4 vf = (f32x4){bflo(rv.x), bfhi(rv.x), bflo(rv.y), bfhi(rv.y)}, ef = (f32x4){bflo(re.x), bfhi(re.x), bflo(re.y), bfhi(re.y)}; \
        const f32x4 af = (f32x4){bflo(ra.x), bfhi(ra.x), bflo(ra.y), bfhi(ra.y)}; \
        f32x4 kkv = kf * kkw; const float ss = red16(kkv[0] * kkv[0] + kkv[1] * kkv[1] + kkv[2] * kkv[2] + kkv[3] * kkv[3]); \
        const float inv = 1.f / fmaxf(sqrtf(ss), 1e-12f); kkv = kkv * inv; \
        const f32x4 km = kf * (1.f + (af - 1.f) * kaw); \
        f32x4 wv; wv[0] = __expf(-ef[0]); wv[1] = __expf(-ef[1]); wv[2] = __expf(-ef[2]); wv[3] = __expf(-ef[3]); \
        const f32x4 t3 = rf * km * rkw; const float rks = red16(t3[0] + t3[1] + t3[2] + t3[3]); \
        float* vb_ = vec + ((buf_) * 32 + rp) * 320 + 4 * q; \
        *(f32x4*)(vb_) = -kkv; *(f32x4*)(vb_ + 64) = wv; *(f32x4*)(vb_ + 128) = kkv * af; *(f32x4*)(vb_ + 192) = km; *(f32x4*)(vb_ + 256) = rf; \
        *(f32x4*)(vvb + ((buf_) * 32 + rp) * 64 + 4 * q) = vf; if (q == 0) rkb[(buf_) * 32 + rp] = rks; } while (0)
#define WKV_FINAL(cc_, fb_) do { \
        unsigned long long* pg_ = xch + ((gbase + (size_t)((cc_) * 32 + rp)) * 2 + (half ^ 1)); unsigned long long pv_; unsigned sp_ = 0u; \
        do { pv_ = __hip_atomic_load(pg_, __ATOMIC_RELAXED, __HIP_MEMORY_SCOPE_AGENT); if ((unsigned)pv_ != 0xFFFFFFFFu) break; __builtin_amdgcn_s_sleep(1); } while (++sp_ < (1u << 22)); \
        const float sm_ = statb[((fb_) * 32 + rp) * 2] + __uint_as_float((unsigned)pv_), sq_ = statb[((fb_) * 32 + rp) * 2 + 1] + __uint_as_float((unsigned)(pv_ >> 32)); \
        const float mean_ = sm_ * (1.f / 64.f), var_ = fmaxf(sq_ * (1.f / 64.f) - mean_ * mean_, 0.f), rstd_ = rsqrtf(var_ + 64e-5f); \
        const float o0_ = ob[((fb_) * 32 + rp) * 32 + 2 * q], o1_ = ob[((fb_) * 32 + rp) * 32 + 2 * q + 1]; \
        const float v0_ = vvb[((fb_) * 32 + rp) * 64 + crow + 2 * q], v1_ = vvb[((fb_) * 32 + rp) * 64 + crow + 2 * q + 1], rks_ = rkb[(fb_) * 32 + rp]; \
        const float y0_ = ((o0_ - mean_) * rstd_ * gw0 + gb0 + v0_ * rks_) * bflo(rgp), y1_ = ((o1_ - mean_) * rstd_ * gw1 + gb1 + v1_ * rks_) * bfhi(rgp); \
        *(unsigned*)(RO + (size_t)(row0 + (cc_) * 32 + rp) * 1024 + c2) = pk2(y0_, y1_); } while (0)
    __syncthreads();
    WKV_LOAD(0); WKV_DERIVE(0);
    __syncthreads();
    for (int c = 0; c < nch; ++c) {
        const int buf = c & 1;
        if (c + 1 < nch) WKV_LOAD(c + 1);
        if (c > 0) rgp = *(const unsigned*)(Gg + (size_t)(row0 + (c - 1) * 32 + rp) * 1024 + c2);
        const float* vb = vec + buf * 32 * 320 + 4 * q; const float* vvp = vvb + buf * 32 * 64 + crow;
        f32x4 n4 = *(const f32x4*)(vb), w4 = *(const f32x4*)(vb + 64), b4 = *(const f32x4*)(vb + 128), k4 = *(const f32x4*)(vb + 192), r4 = *(const f32x4*)(vb + 256);
        float v0 = vvp[rp];
#pragma unroll 4
        for (int t = 0; t < 32; ++t) {
            const int tn = (t + 1) & 31;
            const f32x4 n4n = *(const f32x4*)(vb + tn * 320), w4n = *(const f32x4*)(vb + tn * 320 + 64), b4n = *(const f32x4*)(vb + tn * 320 + 128),
                        k4n = *(const f32x4*)(vb + tn * 320 + 192), r4n = *(const f32x4*)(vb + tn * 320 + 256);
            const float v0n = vvp[tn * 64 + rp];
            const float sa0 = red16(S0[0] * n4[0] + S0[1] * n4[1] + S0[2] * n4[2] + S0[3] * n4[3]);
            S0 = S0 * w4 + (b4 * sa0 + k4 * v0);
            const float o0 = red16(S0[0] * r4[0] + S0[1] * r4[1] + S0[2] * r4[2] + S0[3] * r4[3]);
            if (q == 0) ob[(buf * 32 + t) * 32 + rp] = o0;
            n4 = n4n; w4 = w4n; b4 = b4n; k4 = k4n; r4 = r4n; v0 = v0n;
        }
        __syncthreads();
        {
            const float o0 = ob[(buf * 32 + rp) * 32 + 2 * q], o1 = ob[(buf * 32 + rp) * 32 + 2 * q + 1];
            const float sm = red16(o0 + o1), sq = red16(o0 * o0 + o1 * o1);
            if (q == 0) { statb[(buf * 32 + rp) * 2] = sm; statb[(buf * 32 + rp) * 2 + 1] = sq;
                __hip_atomic_store(xch + ((gbase + (size_t)(c * 32 + rp)) * 2 + half), (unsigned long long)__float_as_uint(sm) | ((unsigned long long)__float_as_uint(sq) << 32), __ATOMIC_RELAXED, __HIP_MEMORY_SCOPE_AGENT); }
        }
        if (c > 0) WKV_FINAL(c - 1, buf ^ 1);
        __syncthreads();
        if (c + 1 < nch) WKV_DERIVE(buf ^ 1);
        __syncthreads();
    }
    rgp = *(const unsigned*)(Gg + (size_t)(row0 + (nch - 1) * 32 + rp) * 1024 + c2);
    WKV_FINAL(nch - 1, (nch - 1) & 1);
    *(f32x4*)(sout + (crow + rp) * 64 + 4 * q) = S0;
#undef WKV_LOAD
#undef WKV_DERIVE
#undef WKV_FINAL
}

#define XB_TMO      128
#define XB_XCNT(j)  (256  + 64 * (j))
#define XB_XSUB(j)  (1280 + 64 * (j))
#define XB_XGEN(j)  (2304 + 64 * (j))
#define XB_TOP      3328
#define XB_TOPGEN   3392
#define XCD_BAR_WORDS 3456
#define XB_SPIN_CAP (1u << 22)
DEV unsigned xb_ld(unsigned* p)              { return __hip_atomic_load(p, __ATOMIC_RELAXED, __HIP_MEMORY_SCOPE_AGENT); }
DEV unsigned xb_add(unsigned* p, unsigned v) { return __hip_atomic_fetch_add(p, v, __ATOMIC_RELAXED, __HIP_MEMORY_SCOPE_AGENT); }
DEV unsigned xb_xcc_id() { return (unsigned)__builtin_amdgcn_s_getreg((3 << 11) | 20) & 0xFu; }
#define XB_SPIN(cond, bar) do { unsigned _sp = 0; while (cond) { __builtin_amdgcn_s_sleep(1); \
    if ((++_sp & 255u) == 0u) { if (xb_ld(&(bar)[XB_TMO])) break; if (_sp > XB_SPIN_CAP) { atomicAdd(&(bar)[XB_TMO], 1u); break; } } } } while (0)
struct XcdBarrier { unsigned* bar; unsigned x; volatile LAS unsigned* st; };
DEV XcdBarrier xcd_barrier_post(unsigned* bar, volatile LAS unsigned* st) {
    XcdBarrier b; b.bar = bar; b.x = xb_xcc_id(); b.st = st;
    if (threadIdx.x == 0) (void)xb_add(&bar[XB_XCNT(b.x)], 1u);
    return b;
}
DEV void xcd_barrier_complete(unsigned* bar, unsigned x, unsigned& nloc, unsigned& nx) {
    const unsigned G = gridDim.x * gridDim.y * gridDim.z;
    unsigned sum, cnt, mine, sp = 0u;
    for (;;) {
        sum = 0u; cnt = 0u; mine = 0u;
#pragma unroll
        for (unsigned j = 0; j < 16; ++j) { const unsigned c = xb_ld(&bar[XB_XCNT(j)]); sum += c; cnt += (c > 0u) ? 1u : 0u; mine = (j == x) ? c : mine; }
        if (sum == G) break;
        __builtin_amdgcn_s_sleep(1);
        if ((++sp & 255u) == 0u) { if (xb_ld(&bar[XB_TMO])) break; if (sp > XB_SPIN_CAP) { atomicAdd(&bar[XB_TMO], 1u); break; } }
    }
    nloc = mine > 0u ? mine : 1u; nx = cnt > 0u ? cnt : 1u;
}
DEV void xcd_barrier(const XcdBarrier& b) {
    asm volatile("s_waitcnt vmcnt(0)" ::: "memory");
    __syncthreads();
    if (threadIdx.x == 0) {
        unsigned* bar = b.bar;
        __builtin_amdgcn_s_waitcnt(0);
        unsigned nloc = b.st[0], nx = b.st[1];
        if (nloc == 0u) { xcd_barrier_complete(bar, b.x, nloc, nx); b.st[0] = nloc; b.st[1] = nx; }
        const unsigned old = xb_add(&bar[XB_XSUB(b.x)], 1u);
        const unsigned gen = old / nloc;
        if (old + 1u == (gen + 1u) * nloc) {
            __builtin_amdgcn_fence(__ATOMIC_RELEASE, "agent");
            asm volatile("s_waitcnt vmcnt(0)" ::: "memory");
            const unsigned og = xb_add(&bar[XB_TOP], 1u);
            const unsigned tg = og / nx;
            if (og + 1u == (tg + 1u) * nx) xb_add(&bar[XB_TOPGEN], 1u);
            else XB_SPIN(xb_ld(&bar[XB_TOPGEN]) == tg, bar);
            __builtin_amdgcn_fence(__ATOMIC_ACQUIRE, "agent");
            xb_add(&bar[XB_XGEN(b.x)], 1u);
            asm volatile("s_waitcnt vmcnt(0)" ::: "memory");
        } else {
            XB_SPIN(xb_ld(&bar[XB_XGEN(b.x)]) == gen, bar);
            __builtin_amdgcn_fence(__ATOMIC_ACQUIRE, "agent");
            asm volatile("s_waitcnt vmcnt(0)" ::: "memory");
        }
    }
    __syncthreads();
}

__global__ void __launch_bounds__(NTHR, 2) mega(KP P) {
    extern __shared__ __attribute__((aligned(16))) unsigned char smem[];
    cg::grid_group grid = cg::this_grid();
    unsigned char* ws = P.ws;
    bf16_t* W = (bf16_t*)ws;
    bf16_t* KB = (bf16_t*)(ws + WS_KB); bf16_t* VT = (bf16_t*)(ws + WS_VT);
    bf16_t* XB = (bf16_t*)(ws + WS_XB); bf16_t* A1 = (bf16_t*)(ws + WS_A1); bf16_t* A2 = (bf16_t*)(ws + WS_A2);
    bf16_t* A3 = (bf16_t*)(ws + WS_A3); bf16_t* A4 = (bf16_t*)(ws + WS_A4); bf16_t* HL = (bf16_t*)(ws + WS_HL);
    bf16_t* D1 = (bf16_t*)P.out; bf16_t* D2 = D1 + E_EL;
    {
        if (threadIdx.x == 0) { *(volatile LAS unsigned*)((LAS unsigned char*)smem + LDS_BYTES - 16) = 0u; *(volatile LAS unsigned*)((LAS unsigned char*)smem + LDS_BYTES - 12) = 0u; }
        __syncthreads();
    }
    const XcdBarrier xbar = xcd_barrier_post((unsigned*)(ws + WS_END), (volatile LAS unsigned*)((LAS unsigned char*)smem + LDS_BYTES - 16));
    for (int ph = P.ph_lo; ph < P.ph_hi; ++ph) {
        GD d; d.mode = -1; d.coff = 0; d.ep = EpiP{nullptr, nullptr, nullptr, nullptr, nullptr, nullptr, nullptr, 0, 0.f};
        int lnidx = -1; int attl = -1;
#define GEMM_SET(A0_, A1_, Bt_, lda_, K_, nt0_, M_, N_, mode_) do { d.g = pg8::Gemm{A0_, A1_, Bt_, lda_, K_, nt0_, M_, N_}; d.mode = mode_; } while (0)
        switch (ph) {
            case 0: prep_phase(P, smem, 0, (int)blockIdx.x, (int)gridDim.x); break;
            case 1: { GD d2; d2.coff = 128; d2.mode = 5; d2.g = pg8::Gemm{A4, A4, W + W_KV, 1024, 1024, 16, 2048, 4096};
                      d2.ep = EpiP{KB, VT, nullptr, nullptr, P.out, nullptr, nullptr, 0, 0.f}; run_gemm(d2, smem); }
            case 12: case 15: case 27: { const int wi = (ph == 1) ? 0 : (ph == 12 ? 1 : (ph == 15 ? 2 : 3));
                      GEMM_SET(XB, XB, W + W_UP + (size_t)wi * 5632 * 1024, 1024, 1024, 16, MTOK, 5632, 1); d.ep.o0 = A1; } break;
            case 2: case 13: case 16: case 28: { const int wi = (ph == 2) ? 0 : (ph == 13 ? 1 : (ph == 16 ? 2 : 3));
                      GEMM_SET(A1, A1, W + W_DN + (size_t)wi * 1024 * 2816, 2816, 2816, 44, MTOK, 1024, 2); d.ep.o0 = XB; d.ep.s = 0.5f; } break;
            case 3: lnidx = 0; break; case 7: lnidx = 1; break; case 11: lnidx = 2; break; case 14: lnidx = 3; break;
            case 17: lnidx = 4; break; case 22: lnidx = 5; break; case 26: lnidx = 6; break; case 29: lnidx = 7; break;
            case 4: GEMM_SET(XB, XB, W + W_IN, 1024, 1024, 16, MTOK, 3072, 0); d.ep.o0 = A1; d.ep.ldc = 3072; break;
            case 5: for (int rep = 0; rep < DBG_MIXREP; ++rep) for (int job = blockIdx.x; job < 288; job += gridDim.x) {
                        if (job < 32) ret_job(job >> 2, job & 3, P, A1, A4, smem);
                        else if (job < 96) lru_job((job - 32) >> 3, (job - 32) & 7, P, A1, A4, smem);
                        else if (job < 160) ret_job(8 + ((job - 96) >> 2), (job - 96) & 3, P, A1, A4, smem);
                        else lru_job(8 + ((job - 160) >> 3), (job - 160) & 7, P, A1, A4, smem);
                    }
                    if (gridDim.x > 128) { if (blockIdx.x >= 96) { __syncthreads(); prep_phase(P, smem, 1, (int)blockIdx.x - 96, (int)gridDim.x - 96); } }
                    else { __syncthreads(); prep_phase(P, smem, 1, (int)blockIdx.x, (int)gridDim.x); }
                    break;
            case 6: GEMM_SET(A4, A4, W + W_O0, 1024, 1024, 16, MTOK, 1024, 2); d.ep.o0 = XB; d.ep.s = 1.f; break;
            case 8: GEMM_SET(XB, XB, W + W_XQ, 1024, 1024, 16, MTOK, 1024, 0); d.ep.o0 = A1; d.ep.ldc = 1024; break;
            case 9: for (int rep = 0; rep < DBG_ATTREP; ++rep) attn_phase(A1, KB, VT, A2, smem); break;
            case 10: GEMM_SET(A2, A2, W + W_XO, 1024, 1024, 16, MTOK, 1024, 2); d.ep.o0 = XB; d.ep.s = 1.f; break;
            case 18: GEMM_SET(XB, A4, W + W_P1, 1024, 2048, 16, MTOK, 3328, 3); d.ep.o0 = A1; d.ep.o1 = A2; d.ep.o2 = A3; d.ep.o3 = HL; break;
            case 19: GEMM_SET(HL, HL, W + W_L2, 256, 256, 4, MTOK, 3072, 4); d.ep.o0 = D1; d.ep.o1 = D2; d.ep.o2 = A4; d.ep.v0 = PIN(31); d.ep.v1 = PIN(34); break;
            case 20: if (gridDim.x == 256) {
                        unsigned long long* xch = (unsigned long long*)(ws + WS_END + 16384);
                        const int hf = blockIdx.x & 1, pj = blockIdx.x >> 1;
                        wkv_half(pj >> 4, pj & 15, hf, P, A1, A2, A3, D1, D2, A4, xch, smem);
                        wkv_half(8 + (pj >> 4), pj & 15, hf, P, A1, A2, A3, D1, D2, A4, xch, smem);
                        wkv_half(8 + ((pj + 128) >> 4), (pj + 128) & 15, hf, P, A1, A2, A3, D1, D2, A4, xch, smem);
                    } else for (int job = blockIdx.x; job < 384; job += gridDim.x) {
                        if (job < 128) wkv_job(job >> 4, job & 15, P, A1, A2, A3, D1, D2, A4, smem, false);
                        else wkv_job(8 + ((job - 128) >> 4), (job - 128) & 15, P, A1, A2, A3, D1, D2, A4, smem, false);
                    } break;
            case 21: GEMM_SET(A1, A1, W + W_O1, 1024, 1024, 16, MTOK, 1024, 2); d.ep.o0 = XB; d.ep.s = 1.f; break;
            case 23: GEMM_SET(XB, XB, W + W_XQ + 1048576, 1024, 1024, 16, MTOK, 1024, 0); d.ep.o0 = A2; d.ep.ldc = 1024; break;
            case 24: attn_phase(A2, KB + (size_t)24 * 256 * 1024, VT + (size_t)24 * 256 * 1024, A3, smem); break;
            case 25: GEMM_SET(A3, A3, W + W_XO + 1048576, 1024, 1024, 16, MTOK, 1024, 2); d.ep.o0 = XB; d.ep.s = 1.f; break;
            default: break;
        }
        if (d.mode >= 0) run_gemm(d, smem);
        if (DBG_GREP > 1 && ph == 4) run_gemm(d, smem);
        if (DBG_LNREP > 1 && lnidx == 0) ln_phase(XB, PIN(10) + lnidx * 1024, PIN(11) + lnidx * 1024, nullptr, nullptr, PIN(6), P.out, P.ph_hi < 1000);
        if (lnidx >= 0) ln_phase(XB, PIN(10) + lnidx * 1024, PIN(11) + lnidx * 1024, lnidx == 4 ? A4 : nullptr, lnidx == 7 ? P.out + O_Y : nullptr, PIN(6), P.out, false);
        (void)attl;
        if (ph == 6) for (int rep = 0; rep < DBG_SYNCREP; ++rep) { __threadfence(); grid.sync(); __builtin_amdgcn_fence(__ATOMIC_ACQUIRE, "agent"); asm volatile("buffer_inv sc1" ::: "memory"); }
        if (ph + 1 < P.ph_hi) {
            if (P.ph_lo == 0x7fffffff) grid.sync();
            xcd_barrier(xbar);
        }
    }
}

extern "C" void kernel_launch(void* const* d_in, const int* in_sizes, int n_in, void* d_out, int out_size, void* d_ws, size_t ws_size, hipStream_t stream) {
    static int grid_blocks = 0;
    if (grid_blocks == 0) {
        if (n_in != 45 || ws_size < WS_END + 16384 + 8519680) { fprintf(stderr, "kernel_launch: unexpected n_in %d or ws_size %zu (< %zu)\n", n_in, ws_size, (size_t)WS_END); grid_blocks = -1; return; }
        int dev = 0, cus = 0, per_cu = 0;
        hipGetDevice(&dev);
        hipDeviceGetAttribute(&cus, hipDeviceAttributeMultiprocessorCount, dev);
        if (hipFuncSetAttribute((const void*)mega, hipFuncAttributeMaxDynamicSharedMemorySize, LDS_BYTES) != hipSuccess) { fprintf(stderr, "kernel_launch: hipFuncSetAttribute failed\n"); grid_blocks = -1; return; }
        hipOccupancyMaxActiveBlocksPerMultiprocessor(&per_cu, (const void*)mega, NTHR, LDS_BYTES);
        if (per_cu < 1) { fprintf(stderr, "kernel_launch: occupancy query returned %d\n", per_cu); per_cu = 1; }
        (void)hipGetLastError();
        grid_blocks = cus * per_cu;
    }
    if (grid_blocks < 0) return;
    if (hipMemsetAsync((char*)d_ws + WS_END, 0, 16384, stream) != hipSuccess) { fprintf(stderr, "kernel_launch: memset of the barrier word failed\n"); return; }
    if (hipMemsetAsync((char*)d_ws + WS_END + 16384, 0xFF, 8519680, stream) != hipSuccess) { fprintf(stderr, "kernel_launch: memset of the exchange granules failed\n"); return; }
    KP p{};
    for (int i = 0; i < 45; ++i) p.in[i] = (const float*)d_in[i];
    p.out = (float*)d_out; p.ws = (unsigned char*)d_ws; p.ph_lo = 0; p.ph_hi = 30;
    void* args[] = {&p};
    hipError_t e = hipLaunchCooperativeKernel((const void*)mega, dim3(grid_blocks), dim3(NTHR), args, LDS_BYTES, stream);
    if (e != hipSuccess) fprintf(stderr, "cooperative launch failed: %s (grid %d)\n", hipGetErrorString(e), grid_blocks);
}
```

```cpp
#include <hip/hip_runtime.h>
#include <hip/hip_cooperative_groups.h>
#include <cstdio>
#include <cstdint>
namespace cg = cooperative_groups;

#define LAS __attribute__((address_space(3)))
#define DEV __device__ __forceinline__
typedef unsigned short bf16_t;
typedef short bf16x8 __attribute__((ext_vector_type(8)));
typedef float f32x4 __attribute__((ext_vector_type(4)));
typedef unsigned u32x4 __attribute__((ext_vector_type(4)));
typedef unsigned u32x2 __attribute__((ext_vector_type(2)));

constexpr int MTOK = 33280, DM = 1024, MPROMPT = 32768, NTHR = 512;
constexpr int LDS_BYTES = 147456;
#define DBG_C 64
#define DBG_C_RET 64
#define DBG_SCANREP 1
#define DBG_MIXREP 1
#define DBG_GREP 1
#define DBG_SYNCREP 0
#define DBG_LNREP 1
#define DBG_ATTREP 1
#define DBG_PREPREP 1
#define DBG_YSCALE 1.0f
#define DBG_SHSCALE 1.0f
#define DBG_WKVSCALE 1.0f
#define DBG_RETSCALE 1.0f
#define DBG_LRUSCALE 1.0f
#define DBG_CONVSCALE 1.0f
constexpr size_t E_EL = (size_t)MTOK * DM;
constexpr size_t W_UP = 0;
constexpr size_t W_DN = W_UP + (size_t)4 * 5632 * 1024;
constexpr size_t W_XQ = W_DN + (size_t)4 * 1024 * 2816;
constexpr size_t W_XO = W_XQ + (size_t)2 * 1048576;
constexpr size_t W_KV = W_XO + (size_t)2 * 1048576;
constexpr size_t W_IN = W_KV + (size_t)4096 * 1024;
constexpr size_t W_O0 = W_IN + (size_t)3072 * 1024;
constexpr size_t W_P1 = W_O0 + (size_t)1048576;
constexpr size_t W_L2 = W_P1 + (size_t)3328 * 2048;
constexpr size_t W_O1 = W_L2 + (size_t)3072 * 256;
constexpr size_t W_END = W_O1 + (size_t)1048576;
constexpr size_t KV_EL = (size_t)2 * 24 * 256 * 1024;
constexpr size_t WS_KB = W_END * 2;
constexpr size_t WS_VT = WS_KB + KV_EL * 2;
constexpr size_t WS_XB = WS_VT + KV_EL * 2;
constexpr size_t WS_A1 = WS_XB + E_EL * 2;
constexpr size_t WS_A2 = WS_A1 + E_EL * 2;
constexpr size_t WS_A3 = WS_A2 + E_EL * 2;
constexpr size_t WS_A4 = WS_A3 + E_EL * 2;
constexpr size_t WS_HL = WS_A4 + E_EL * 2;
constexpr size_t WS_END = WS_HL + (size_t)MTOK * 256 * 2;
constexpr size_t O_Y = 0, O_MK = 34078720, O_MV = 38273024, O_PCONV = 42467328, O_PLRU = 42479616, O_PRET = 42483712,
                 O_PSHIFT = 43008000, O_PWKV = 43016192, O_SCONV = 43540480, O_SLRU = 43565056, O_SRET = 43573248,
                 O_SSHIFT = 44621824, O_SWKV = 44638208;

struct KP { const float* in[45]; float* out; unsigned char* ws; int ph_lo, ph_hi; };

DEV int ltid() { int t = threadIdx.x; asm volatile("" : "+v"(t)); return t; }
DEV const float* pin(const KP& P, int k) { asm volatile("" : "+s"(k)); return P.in[k]; }
#define PIN(k) pin(P, k)
typedef float f32x2_t __attribute__((ext_vector_type(2)));
typedef __bf16 bf16x2_t __attribute__((ext_vector_type(2)));
DEV unsigned pk2(float lo, float hi) { const f32x2_t v = {lo, hi}; return __builtin_bit_cast(unsigned, __builtin_convertvector(v, bf16x2_t)); }
DEV float bflo(unsigned u) { return __uint_as_float(u << 16); }
DEV float bfhi(unsigned u) { return __uint_as_float(u & 0xffff0000u); }
DEV float bf1(bf16_t b) { return __uint_as_float(((unsigned)b) << 16); }
DEV bf16_t f2bf(float f) { return (bf16_t)(pk2(f, f) & 0xffffu); }
DEV float sigmoidf_(float x) { return __builtin_amdgcn_rcpf(1.f + __expf(-x)); }
DEV float tanhf_(float x) { return 1.f - 2.f / (__expf(2.f * x) + 1.f); }
template <int CTRL> DEV float dppf(float v) { return __builtin_bit_cast(float, __builtin_amdgcn_update_dpp(0, __builtin_bit_cast(int, v), CTRL, 0xf, 0xf, true)); }
DEV float red8(float v) { v += dppf<0xB1>(v); v += dppf<0x4E>(v); v += dppf<0x141>(v); return v; }
DEV float red16(float v) { v = red8(v); v += dppf<0x140>(v); return v; }
DEV float wave_sum(float v) {
#pragma unroll
    for (int o = 1; o < 64; o <<= 1) v += __shfl_xor(v, o);
    return v;
}
DEV void unpack8(u32x4 u, float* f) { f[0] = bflo(u.x); f[1] = bfhi(u.x); f[2] = bflo(u.y); f[3] = bfhi(u.y); f[4] = bflo(u.z); f[5] = bfhi(u.z); f[6] = bflo(u.w); f[7] = bfhi(u.w); }
DEV u32x4 pack8(const float* f) { u32x4 o; o.x = pk2(f[0], f[1]); o.y = pk2(f[2], f[3]); o.z = pk2(f[4], f[5]); o.w = pk2(f[6], f[7]); return o; }
DEV f32x4 mfma16(bf16x8 a, bf16x8 b, f32x4 c) { return __builtin_amdgcn_mfma_f32_16x16x32_bf16(a, b, c, 0, 0, 0); }

namespace pg8 {
constexpr int BM = 256, BK = 64, HALF = 128, HTB = HALF * BK * 2, NXCD = 8, WGM = 8;
DEV int lds_byte(int r, int c) { const int st = (r >> 4) * 2 + (c >> 5), rr = r & 15, cc = c & 31, ob = rr * 64 + cc * 2; return st * 1024 + (ob ^ (((ob >> 9) & 1) << 5)); }
DEV void stage_rc(int b, int& R, int& C) { const int st = b / 1024, sb = b % 1024, swz = sb ^ (((sb >> 9) & 1) << 5); R = (st >> 1) * 16 + swz / 64; C = (st & 1) * 32 + (swz % 64) / 2; }
DEV int perm32(int rho) { const int n = rho >> 4, i = rho & 15; return 8 * (i >> 2) + 4 * n + (i & 3); }
struct Unit { int pm, pn; };
struct Gemm { const bf16_t* A0; const bf16_t* A1; const bf16_t* Bt; int lda, K, nt0, M, N; };
struct StaticOrder {
    int nM, nN, nwg, G, c;
    DEV void init(int M, int N, int G_, int c_) { nM = M / BM; nN = N / BM; nwg = nM * nN; G = G_; c = c_; }
    DEV bool next(int i, Unit& u) const {
        const long L = (long)i * G + c; if (L >= nwg) return false;
        int wgid = (int)L; { const int q = nwg / NXCD, r = nwg % NXCD, xcd = wgid % NXCD, off = wgid / NXCD; wgid = (xcd < r ? xcd * (q + 1) : r * (q + 1) + (xcd - r) * q) + off; }
        const int nig = WGM * nN, gid = wgid / nig, fm = gid * WGM, gsz = (nM - fm) < WGM ? (nM - fm) : WGM;
        u.pm = fm + ((wgid % nig) % gsz); u.pn = (wgid % nig) / gsz; return true;
    }
};

template <class Epi>
DEV void gemm_phase(LAS unsigned char* lds, const Gemm g, const StaticOrder& S, const Epi& E) {
    const int tid = ltid(), wid = __builtin_amdgcn_readfirstlane(tid >> 6), lane = tid & 63, wr = wid >> 2, wc = wid & 3, fr = lane & 15, fq = lane >> 4;
    const int K = g.K, nt = K / BK, lda = g.lda, nt0 = g.nt0;
    unsigned voffA[2], voffB[2];
#pragma unroll
    for (int i = 0; i < 2; ++i) { int R, C; stage_rc(tid * 16 + i * 8192, R, C); const int Rb = (R & ~31) + perm32(R & 31);
        voffA[i] = (unsigned)(R * lda + C) * 2u; voffB[i] = (unsigned)(Rb * K + C) * 2u; }
    const size_t kstep = (size_t)(BK * 2);
    const size_t hstepA = (size_t)HALF * lda * 2, hstepB = (size_t)HALF * K * 2;
    const size_t tstepA = 2 * hstepA, tstepB = 2 * hstepB;
    const unsigned ldsw = (unsigned)wid * 1024u;
    const int aoff = lds_byte(wr * 64 + fr, fq * 8), boff = lds_byte(wc * 32 + fr, fq * 8);
    const char* const gA0 = (const char*)g.A0; const char* const gA1 = (const char*)g.A1 - (size_t)nt0 * kstep;
#define PG8_AK(rowoff, kt) (((kt) < nt0 ? gA0 : gA1) + (rowoff) + (size_t)(kt) * kstep)
#define PG8_SA(b, h) (((b) * 2 + (h)) * HTB)
#define PG8_SB(b, h) ((4 + (b) * 2 + (h)) * HTB)
#define PG8_STAGE(bufoff, gbase, voff) do { _Pragma("unroll") for (int _i = 0; _i < 2; ++_i) \
        __builtin_amdgcn_global_load_lds((const unsigned*)((const char*)(gbase) + (voff)[_i]), (LAS unsigned*)(lds + (bufoff) + ldsw + _i * 8192), 16, 0, 0); } while (0)
#define PG8_LDA(dst, b, h) do { _Pragma("unroll") for (int m = 0; m < 4; ++m) _Pragma("unroll") for (int k = 0; k < 2; ++k) dst[m][k] = *(const LAS bf16x8*)(lds + PG8_SA(b, h) + aoff + m * 2048 + k * 1024); } while (0)
#define PG8_LDB(dst, b, h) do { _Pragma("unroll") for (int n = 0; n < 2; ++n) _Pragma("unroll") for (int k = 0; k < 2; ++k) dst[n][k] = *(const LAS bf16x8*)(lds + PG8_SB(b, h) + boff + n * 2048 + k * 1024); } while (0)
#define PG8_MMA(ai, bj, At, Bt) do { __builtin_amdgcn_s_setprio(1); _Pragma("unroll") for (int m = 0; m < 4; ++m) _Pragma("unroll") for (int n = 0; n < 2; ++n) _Pragma("unroll") for (int k = 0; k < 2; ++k) \
        acc[ai][bj][m][n] = __builtin_amdgcn_mfma_f32_16x16x32_bf16(Bt[n][k], At[m][k], acc[ai][bj][m][n], 0, 0, 0); __builtin_amdgcn_s_setprio(0); } while (0)
#define PG8_WAIT_V(n) asm volatile("s_waitcnt vmcnt(" #n ")" ::: "memory")
#define PG8_WAIT_L(n) asm volatile("s_waitcnt lgkmcnt(" #n ")" ::: "memory")
#define PG8_BAR __builtin_amdgcn_s_barrier()
#define PG8_SCHED __builtin_amdgcn_sched_barrier(0)
    Unit cur, nxt; int ui = 0;
    if (!S.next(0, cur)) return;
    f32x4 acc[2][2][4][2];
#pragma unroll
    for (int a = 0; a < 2; ++a)
#pragma unroll
        for (int b = 0; b < 2; ++b)
#pragma unroll
            for (int m = 0; m < 4; ++m)
#pragma unroll
                for (int n = 0; n < 2; ++n) acc[a][b][m][n] = (f32x4){0.f, 0.f, 0.f, 0.f};
    bf16x8 At[4][2], B0[2][2], B1[2][2];
    size_t cAo = (size_t)cur.pm * tstepA; const char* cB = (const char*)g.Bt + (size_t)cur.pn * tstepB;
    { const char* a0p = PG8_AK(cAo, 0); const char* a1p = PG8_AK(cAo, 1);
      PG8_STAGE(PG8_SB(0, 0), cB, voffB); PG8_STAGE(PG8_SB(0, 1), cB + hstepB, voffB); PG8_STAGE(PG8_SA(0, 0), a0p, voffA); PG8_STAGE(PG8_SA(0, 1), a0p + hstepA, voffA);
      if (wr == 1) PG8_BAR;
      PG8_WAIT_V(2); PG8_BAR;
      PG8_STAGE(PG8_SB(1, 0), cB + kstep, voffB); PG8_STAGE(PG8_SA(1, 0), a1p, voffA); PG8_STAGE(PG8_SB(1, 1), cB + hstepB + kstep, voffB);
      PG8_WAIT_V(6); PG8_BAR; }
    for (;;) {
        const bool has_next = S.next(ui + 1, nxt);
        const size_t nAo = has_next ? (size_t)nxt.pm * tstepA : cAo; const char* nB = has_next ? (const char*)g.Bt + (size_t)nxt.pn * tstepB : cB;
        for (int t = 0; t < nt; t += 2) {
            const bool last = (t == nt - 2);
            const char* a1 = PG8_AK(cAo, t + 1);
            const char* a2 = last ? PG8_AK(nAo, 0) : PG8_AK(cAo, t + 2); const char* b2 = last ? nB : cB + (size_t)(t + 2) * kstep;
            const char* a3 = last ? PG8_AK(nAo, 1) : PG8_AK(cAo, t + 3); const char* b3 = b2 + kstep;
            PG8_LDB(B0, 0, 0); PG8_LDB(B1, 0, 1); PG8_SCHED; PG8_LDA(At, 0, 0); PG8_STAGE(PG8_SA(1, 1), a1 + hstepA, voffA);
            PG8_WAIT_V(8); PG8_WAIT_L(0); PG8_BAR; PG8_MMA(0, 0, At, B0); PG8_MMA(0, 1, At, B1); PG8_BAR; PG8_SCHED;
            PG8_LDA(At, 0, 1); PG8_STAGE(PG8_SB(0, 0), b2, voffB); PG8_STAGE(PG8_SB(0, 1), b2 + hstepB, voffB); PG8_STAGE(PG8_SA(0, 0), a2, voffA);
            PG8_WAIT_V(8); PG8_WAIT_L(0); PG8_BAR; PG8_MMA(1, 0, At, B0); PG8_MMA(1, 1, At, B1); PG8_BAR; PG8_SCHED;
            PG8_LDB(B0, 1, 0); PG8_LDB(B1, 1, 1); PG8_SCHED; PG8_LDA(At, 1, 0); PG8_STAGE(PG8_SA(0, 1), a2 + hstepA, voffA);
            PG8_WAIT_V(8); PG8_WAIT_L(0); PG8_BAR; PG8_MMA(0, 0, At, B0); PG8_MMA(0, 1, At, B1); PG8_BAR; PG8_SCHED;
            PG8_LDA(At, 1, 1); PG8_STAGE(PG8_SB(1, 0), b3, voffB); PG8_STAGE(PG8_SB(1, 1), b3 + hstepB, voffB); PG8_STAGE(PG8_SA(1, 0), a3, voffA);
            PG8_WAIT_V(8); PG8_WAIT_L(0); PG8_BAR; PG8_MMA(1, 0, At, B0); PG8_MMA(1, 1, At, B1); PG8_BAR; PG8_SCHED;
        }
        if (wr == 0) PG8_BAR;
        E(acc, cur, wr, wc, fr, fq);
        if (!has_next) break;
#pragma unroll
        for (int a = 0; a < 2; ++a)
#pragma unroll
            for (int b = 0; b < 2; ++b)
#pragma unroll
                for (int m = 0; m < 4; ++m)
#pragma unroll
                    for (int n = 0; n < 2; ++n) acc[a][b][m][n] = (f32x4){0.f, 0.f, 0.f, 0.f};
        cur = nxt; cAo = nAo; cB = nB; ++ui;
        if (wr == 1) PG8_BAR;
    }
    PG8_WAIT_V(0);
    PG8_BAR;
#undef PG8_AK
#undef PG8_SA
#undef PG8_SB
#undef PG8_STAGE
#undef PG8_LDA
#undef PG8_LDB
#undef PG8_MMA
#undef PG8_WAIT_V
#undef PG8_WAIT_L
#undef PG8_BAR
#undef PG8_SCHED
}
}

struct EpiP { bf16_t* o0; bf16_t* o1; bf16_t* o2; bf16_t* o3; float* f0; const float* v0; const float* v1; int ldc; float s; };
typedef f32x4 AccT[2][2][4][2];
template <int MODE> struct Epi {
    EpiP p;
    DEV void operator()(const AccT& acc, const pg8::Unit& u, int wr, int wc, int fr, int fq) const {
        const int row0 = u.pm * 256 + wr * 64 + fr;
        const int cl = wc * 32 + 8 * fq;
#pragma unroll
        for (int ai = 0; ai < 2; ++ai)
#pragma unroll
            for (int m = 0; m < 4; ++m) {
                const size_t row = (size_t)(row0 + ai * 128 + m * 16);
                if (MODE == 1) {
                    float h[8];
#pragma unroll
                    for (int n = 0; n < 2; ++n)
#pragma unroll
                        for (int i = 0; i < 4; ++i) { const float gt = acc[ai][0][m][n][i], up = acc[ai][1][m][n][i]; h[n * 4 + i] = gt * sigmoidf_(gt) * up; }
                    *(u32x4*)(p.o0 + row * 2816 + u.pn * 128 + cl) = pack8(h);
                } else {
#pragma unroll
                    for (int bj = 0; bj < 2; ++bj) {
                        float v[8];
#pragma unroll
                        for (int n = 0; n < 2; ++n)
#pragma unroll
                            for (int i = 0; i < 4; ++i) v[n * 4 + i] = acc[ai][bj][m][n][i];
                        const int col = u.pn * 256 + bj * 128 + cl;
                        if (MODE == 0) {
                            *(u32x4*)(p.o0 + row * p.ldc + col) = pack8(v);
                        } else if (MODE == 2) {
                            bf16_t* xp = p.o0 + row * 1024 + col; float x[8]; unpack8(*(const u32x4*)xp, x);
#pragma unroll
                            for (int i = 0; i < 8; ++i) x[i] = 1.41421356237f * x[i] + p.s * v[i];
                            *(u32x4*)xp = pack8(x);
                        } else if (MODE == 3) {
                            if (u.pn < 12) { bf16_t* base = p.o0 + (size_t)(u.pn >> 2) * E_EL;
                                *(u32x4*)(base + row * 1024 + (col & 1023)) = pack8(v);
                            } else { const int c = bj * 128 + cl;
                                if (bj == 1) {
#pragma unroll
                                    for (int i = 0; i < 8; ++i) v[i] = sigmoidf_(v[i]);
                                } else if (wc < 2) {
#pragma unroll
                                    for (int i = 0; i < 8; ++i) v[i] = tanhf_(v[i]);
                                }
                                *(u32x4*)(p.o3 + row * 256 + c) = pack8(v); }
                        } else if (MODE == 4) {
                            const int c = col & 1023;
                            if (u.pn < 4) {
#pragma unroll
                                for (int i = 0; i < 8; ++i) v[i] = 0.60653066f * sigmoidf_(p.v0[c + i] + v[i]);
                                *(u32x4*)(p.o0 + row * 1024 + c) = pack8(v);
                            } else if (u.pn < 8) {
#pragma unroll
                                for (int i = 0; i < 8; ++i) v[i] = sigmoidf_(p.v1[c + i] + v[i]);
                                *(u32x4*)(p.o1 + row * 1024 + c) = pack8(v);
                            } else *(u32x4*)(p.o2 + row * 1024 + c) = pack8(v);
                        } else if (MODE == 5) {
                            const int which = col >> 10, c = col & 1023, l = which & 1;
                            float* fo = p.f0 + (which < 2 ? O_MK : O_MV) + (size_t)l * 2097152 + row * 1024 + c;
                            *(f32x4*)fo = (f32x4){v[0], v[1], v[2], v[3]}; *(f32x4*)(fo + 4) = (f32x4){v[4], v[5], v[6], v[7]};
                            const int b = (int)(row >> 8), mem = (int)(row & 255);
                            if (which < 2) { *(u32x4*)(p.o0 + ((size_t)(l * 24 + b) * 256 + mem) * 1024 + c) = pack8(v); }
                            else { const int hh = c >> 8, d = c & 255; bf16_t* vt = p.o1 + ((size_t)((l * 24 + b) * 4 + hh) * 256 + d) * 256 + mem;
#pragma unroll
                                for (int i = 0; i < 8; ++i) vt[(size_t)i * 256] = f2bf(v[i]); }
                        }
                    }
                }
            }
    }
};

struct GD { pg8::Gemm g; EpiP ep; int mode; int coff; };
DEV void run_gemm(const GD& d, unsigned char* smem) {
    pg8::StaticOrder S; const int G = gridDim.x; S.init(d.g.M, d.g.N, G, (int)((blockIdx.x + d.coff) % G));
    LAS unsigned char* lds = (LAS unsigned char*)smem;
    switch (d.mode) {
        case 0: { Epi<0> e{d.ep}; pg8::gemm_phase(lds, d.g, S, e); } break;
        case 1: { Epi<1> e{d.ep}; pg8::gemm_phase(lds, d.g, S, e); } break;
        case 2: { Epi<2> e{d.ep}; pg8::gemm_phase(lds, d.g, S, e); } break;
        case 3: { Epi<3> e{d.ep}; pg8::gemm_phase(lds, d.g, S, e); } break;
        case 4: { Epi<4> e{d.ep}; pg8::gemm_phase(lds, d.g, S, e); } break;
        default: { Epi<5> e{d.ep}; pg8::gemm_phase(lds, d.g, S, e); } break;
    }
}

DEV void tconv_tile(const float* src, int ld, int col0, int k0, bf16_t* dst, int ldd, int n0, int kd0, const float* mu, int smode, float* tile) {
    const int tid = ltid();
#pragma unroll
    for (int i = 0; i < 2; ++i) {
        const int kk = (tid >> 4) + 32 * i, c4 = (tid & 15) * 4;
        const f32x4 v = *(const f32x4*)(src + (size_t)(k0 + kk) * ld + col0 + c4);
        float sc = 1.f; if (smode) { const float m = mu[k0 + kk]; sc = (smode == 1) ? (1.f - m) : m; }
        tile[kk * 65 + c4 + 0] = v[0] * sc; tile[kk * 65 + c4 + 1] = v[1] * sc; tile[kk * 65 + c4 + 2] = v[2] * sc; tile[kk * 65 + c4 + 3] = v[3] * sc;
    }
    __syncthreads();
    const int nn = tid >> 3, kc = (tid & 7) * 8;
    u32x4 o; o.x = pk2(tile[(kc + 0) * 65 + nn], tile[(kc + 1) * 65 + nn]); o.y = pk2(tile[(kc + 2) * 65 + nn], tile[(kc + 3) * 65 + nn]);
    o.z = pk2(tile[(kc + 4) * 65 + nn], tile[(kc + 5) * 65 + nn]); o.w = pk2(tile[(kc + 6) * 65 + nn], tile[(kc + 7) * 65 + nn]);
    *(u32x4*)(dst + (size_t)(n0 + nn) * ldd + kd0 + kc) = o;
    __syncthreads();
}
DEV void tconv_mat(const float* src, int ld, int K, int N, bf16_t* dst, int ldd, int kd0, int cmap, const float* mu, int smode, float* tile, int& base, int vb, int G) {
    const int nkb = K / 64, nt = nkb * (N / 64);
    const int start = (int)((vb + G - (base % G)) % G);
    for (int t = start; t < nt; t += G) {
        const int nb = t / nkb, kb = t % nkb; int col0 = nb * 64;
        if (cmap == 1) { const int pn = nb >> 2, bj = (nb >> 1) & 1, jb = nb & 1; col0 = bj * 2816 + pn * 128 + jb * 64; }
        tconv_tile(src, ld, col0, kb * 64, dst, ldd, nb * 64, kd0 + kb * 64, mu, smode, tile);
    }
    base += nt;
}
DEV void cvt_flat(const float* src, bf16_t* dst, size_t n8, int vb, int G) {
    for (size_t i = (size_t)vb * NTHR + ltid(); i < n8; i += (size_t)G * NTHR) {
        const f32x4 a = *(const f32x4*)(src + i * 8), b = *(const f32x4*)(src + i * 8 + 4);
        u32x4 o; o.x = pk2(a[0], a[1]); o.y = pk2(a[2], a[3]); o.z = pk2(b[0], b[1]); o.w = pk2(b[2], b[3]);
        *(u32x4*)(dst + i * 8) = o;
    }
}
DEV void prep_phase(const KP& P, unsigned char* smem, int part, int vb, int G) {
    float* tile = (float*)smem; bf16_t* W = (bf16_t*)P.ws; int base = 0;
    bf16_t* VT = (bf16_t*)(P.ws + WS_VT); bf16_t* KB = (bf16_t*)(P.ws + WS_KB);
#define TC(...) tconv_mat(__VA_ARGS__, tile, base, vb, G)
    for (int i = 2 * part; i < 2 * part + 2; ++i) TC(PIN(12) + (size_t)i * 1024 * 5632, 5632, 1024, 5632, W + W_UP + (size_t)i * 5632 * 1024, 1024, 0, 1, nullptr, 0);
    for (int i = 2 * part; i < 2 * part + 2; ++i) TC(PIN(13) + (size_t)i * 2816 * 1024, 1024, 2816, 1024, W + W_DN + (size_t)i * 1024 * 2816, 2816, 0, 0, nullptr, 0);
    { const int l = part;
        TC(PIN(14) + (size_t)l * 1048576, 1024, 1024, 1024, W + W_XQ + (size_t)l * 1048576, 1024, 0, 0, nullptr, 0);
        TC(PIN(17) + (size_t)l * 1048576, 1024, 1024, 1024, W + W_XO + (size_t)l * 1048576, 1024, 0, 0, nullptr, 0); }
    if (part == 0) {
        for (int l = 0; l < 2; ++l) {
            TC(PIN(15) + (size_t)l * 1048576, 1024, 1024, 1024, W + W_KV + (size_t)l * 1048576, 1024, 0, 0, nullptr, 0);
            TC(PIN(16) + (size_t)l * 1048576, 1024, 1024, 1024, W + W_KV + (size_t)(2 + l) * 1048576, 1024, 0, 0, nullptr, 0); }
        TC(PIN(18), 3072, 1024, 3072, W + W_IN, 1024, 0, 0, nullptr, 0);
        TC(PIN(28), 1024, 1024, 1024, W + W_O0, 1024, 0, 0, nullptr, 0);
    } else {
        for (int p = 0; p < 3; ++p) {
            TC(PIN(30) + (size_t)p * 1048576, 1024, 1024, 1024, W + W_P1 + (size_t)p * 1024 * 2048, 2048, 0, 0, PIN(29) + p * 1024, 1);
            TC(PIN(30) + (size_t)p * 1048576, 1024, 1024, 1024, W + W_P1 + (size_t)p * 1024 * 2048, 2048, 1024, 0, PIN(29) + p * 1024, 2); }
        TC(PIN(32), 64, 1024, 64, W + W_P1 + (size_t)3072 * 2048, 2048, 0, 0, PIN(29) + 3 * 1024, 1);
        TC(PIN(32), 64, 1024, 64, W + W_P1 + (size_t)3072 * 2048, 2048, 1024, 0, PIN(29) + 3 * 1024, 2);
        TC(PIN(35), 64, 1024, 64, W + W_P1 + (size_t)3136 * 2048, 2048, 0, 0, PIN(29) + 4 * 1024, 1);
        TC(PIN(35), 64, 1024, 64, W + W_P1 + (size_t)3136 * 2048, 2048, 1024, 0, PIN(29) + 4 * 1024, 2);
        TC(PIN(37), 128, 1024, 128, W + W_P1 + (size_t)3200 * 2048, 2048, 0, 0, PIN(29) + 5 * 1024, 1);
        TC(PIN(37), 128, 1024, 128, W + W_P1 + (size_t)3200 * 2048, 2048, 1024, 0, PIN(29) + 5 * 1024, 2);
        TC(PIN(44), 1024, 1024, 1024, W + W_O1, 1024, 0, 0, nullptr, 0);
    }
    for (int j = 64 * part; j < 64 * part + 64; ++j) { const int l = j >> 6, b = (j >> 2) & 15, h = j & 3;
        TC(PIN(9) + (size_t)((l * 16 + b) * 256) * 1024 + h * 256, 1024, 256, 256, VT + (size_t)((l * 24 + 8 + b) * 4 + h) * 65536, 256, 0, 0, nullptr, 0); }
#undef TC
    { const int l = part; cvt_flat(PIN(8) + (size_t)l * 16 * 256 * 1024, KB + (size_t)(l * 24 + 8) * 256 * 1024, (size_t)16 * 256 * 1024 / 8, vb, G); }
    if (part == 0) {
        bf16_t* XB = (bf16_t*)(P.ws + WS_XB);
        cvt_flat(PIN(0), XB, (size_t)MPROMPT * 1024 / 8, vb, G);
        cvt_flat(PIN(1), XB + (size_t)MPROMPT * 1024, (size_t)512 * 1024 / 8, vb, G);
        cvt_flat(PIN(2), (bf16_t*)(P.ws + WS_A4), (size_t)2048 * 1024 / 8, vb, G);
    } else {
        for (int i = vb * NTHR + ltid(); i < 3072 * 32; i += G * NTHR) {
            const int n = i >> 5, kc = (i & 31) * 8; float v[8];
#pragma unroll
            for (int j = 0; j < 8; ++j) { const int k = kc + j; float x = 0.f;
                if (n < 1024) { if (k < 64) x = PIN(33)[(size_t)k * 1024 + n]; }
                else if (n < 2048) { if (k >= 64 && k < 128) x = PIN(36)[(size_t)(k - 64) * 1024 + (n - 1024)]; }
                else { if (k >= 128) x = PIN(38)[(size_t)(k - 128) * 1024 + (n - 2048)]; }
                v[j] = x; }
            *(u32x4*)(W + W_L2 + (size_t)n * 256 + kc) = pack8(v);
        }
    }
}

DEV void ln_phase(bf16_t* X, const float* g, const float* b, bf16_t* Xp, float* outf, const float* shift_in, float* outbase, bool dry) {
    const int lane = ltid() & 63, wave = ltid() >> 6;
    float gg[16], bb[16];
#pragma unroll
    for (int j = 0; j < 8; ++j) { gg[j] = g[lane * 8 + j]; gg[8 + j] = g[512 + lane * 8 + j]; bb[j] = b[lane * 8 + j]; bb[8 + j] = b[512 + lane * 8 + j]; }
    u32x4 na = (u32x4){0u, 0u, 0u, 0u}, nb = na;
    { const int r0 = blockIdx.x * 8 + wave; if (r0 < MTOK) { na = *(const u32x4*)(X + (size_t)r0 * 1024 + lane * 8); nb = *(const u32x4*)(X + (size_t)r0 * 1024 + 512 + lane * 8); } }
    for (int row = blockIdx.x * 8 + wave; row < MTOK; row += gridDim.x * 8) {
        bf16_t* xr = X + (size_t)row * 1024;
        float v[16]; unpack8(na, v); unpack8(nb, v + 8);
        { const int nr = row + gridDim.x * 8; if (nr < MTOK) { na = *(const u32x4*)(X + (size_t)nr * 1024 + lane * 8); nb = *(const u32x4*)(X + (size_t)nr * 1024 + 512 + lane * 8); } }
        float s = 0.f;
#pragma unroll
        for (int j = 0; j < 16; ++j) s += v[j];
        const float mean = wave_sum(s) * (1.f / 1024.f); float s2 = 0.f;
#pragma unroll
        for (int j = 0; j < 16; ++j) { v[j] -= mean; s2 += v[j] * v[j]; }
        const float rstd = rsqrtf(wave_sum(s2) * (1.f / 1024.f) + 1e-5f);
#pragma unroll
        for (int j = 0; j < 16; ++j) v[j] = v[j] * rstd * gg[j] + bb[j];
        const u32x4 o0 = pack8(v), o1 = pack8(v + 8);
        if (!dry) { *(u32x4*)(xr + lane * 8) = o0; *(u32x4*)(xr + 512 + lane * 8) = o1; }
        if (outf) { float* fo = outf + (size_t)row * 1024;
#pragma unroll
            for (int j = 0; j < 16; ++j) v[j] *= DBG_YSCALE;
            *(f32x4*)(fo + lane * 8) = (f32x4){v[0], v[1], v[2], v[3]}; *(f32x4*)(fo + lane * 8 + 4) = (f32x4){v[4], v[5], v[6], v[7]};
            *(f32x4*)(fo + 512 + lane * 8) = (f32x4){v[8], v[9], v[10], v[11]}; *(f32x4*)(fo + 512 + lane * 8 + 4) = (f32x4){v[12], v[13], v[14], v[15]}; }
        if (Xp) {
            int t, T, bidx; const bool prompt = row < MPROMPT;
            if (prompt) { bidx = row >> 12; t = row & 4095; T = 4096; } else { const int r2 = row - MPROMPT; bidx = r2 >> 5; t = r2 & 31; T = 32; }
            if (t + 1 < T) { bf16_t* xn = Xp + (size_t)(row + 1) * 1024; *(u32x4*)(xn + lane * 8) = o0; *(u32x4*)(xn + 512 + lane * 8) = o1; }
            else { float* so = outbase + (prompt ? O_PSHIFT : O_SSHIFT) + (size_t)bidx * 1024;
#pragma unroll
                for (int j = 0; j < 16; ++j) v[j] *= DBG_SHSCALE;
                *(f32x4*)(so + lane * 8) = (f32x4){v[0], v[1], v[2], v[3]}; *(f32x4*)(so + lane * 8 + 4) = (f32x4){v[4], v[5], v[6], v[7]};
                *(f32x4*)(so + 512 + lane * 8) = (f32x4){v[8], v[9], v[10], v[11]}; *(f32x4*)(so + 512 + lane * 8 + 4) = (f32x4){v[12], v[13], v[14], v[15]}; }
            if (t == 0) { bf16_t* x0 = Xp + (size_t)row * 1024; float z[16];
#pragma unroll
                for (int j = 0; j < 8; ++j) { z[j] = prompt ? 0.f : shift_in[(size_t)bidx * 1024 + lane * 8 + j]; z[8 + j] = prompt ? 0.f : shift_in[(size_t)bidx * 1024 + 512 + lane * 8 + j]; }
                *(u32x4*)(x0 + lane * 8) = pack8(z); *(u32x4*)(x0 + 512 + lane * 8) = pack8(z + 8); }
        }
    }
}

DEV void attn_phase(const bf16_t* Q, const bf16_t* KBl, const bf16_t* VTl, bf16_t* AO, unsigned char* smem) {
    const int tid = ltid(), lane = tid & 63, wave = tid >> 6, fr = lane & 15, g = lane >> 4;
    bf16_t* Ks = (bf16_t*)smem;
    bf16_t* Vs = (bf16_t*)(smem + 64 * 264 * 2);
    for (int job = blockIdx.x; job < 1088; job += gridDim.x) {
        int s, h, row0, nvalid;
        if (job < 1024) { s = job >> 7; h = (job >> 5) & 3; row0 = s * 4096 + (job & 31) * 128; nvalid = 128; }
        else { const int j2 = job - 1024; s = 8 + (j2 >> 2); h = j2 & 3; row0 = MPROMPT + (s - 8) * 32; nvalid = 32; }
        const int myrow = wave * 16 + fr; const bool valid = myrow < nvalid;
        const bf16_t* qp = Q + (size_t)(row0 + (valid ? myrow : 0)) * 1024 + h * 256 + g * 8;
        bf16x8 qf[8];
#pragma unroll
        for (int s8 = 0; s8 < 8; ++s8) qf[s8] = *(const bf16x8*)(qp + s8 * 32);
        f32x4 sc[16];
#pragma unroll
        for (int i = 0; i < 16; ++i) sc[i] = (f32x4){0.f, 0.f, 0.f, 0.f};
        const bf16_t* Kg = KBl + (size_t)s * 256 * 1024 + h * 256;
        const bf16_t* Vg = VTl + (size_t)(s * 4 + h) * 65536;
        u32x4 pre[4];
#pragma unroll
        for (int i = 0; i < 4; ++i) { const int ch = tid + i * 512, key = ch >> 5, dc = (ch & 31) * 8; pre[i] = *(const u32x4*)(Kg + (size_t)key * 1024 + dc); }
#pragma unroll
        for (int kt4 = 0; kt4 < 4; ++kt4) {
            __syncthreads();
#pragma unroll
            for (int i = 0; i < 4; ++i) { const int ch = tid + i * 512, key = ch >> 5, dc = (ch & 31) * 8; *(u32x4*)(Ks + key * 264 + dc) = pre[i]; }
            __syncthreads();
            if (kt4 < 3) {
#pragma unroll
                for (int i = 0; i < 4; ++i) { const int ch = tid + i * 512, key = ch >> 5, dc = (ch & 31) * 8; pre[i] = *(const u32x4*)(Kg + (size_t)((kt4 + 1) * 64 + key) * 1024 + dc); }
            } else {
#pragma unroll
                for (int i = 0; i < 4; ++i) { const int ch = tid + i * 512, d = ch >> 3, kc = (ch & 7) * 8; pre[i] = *(const u32x4*)(Vg + (size_t)d * 256 + kc); }
            }
#pragma unroll
            for (int kt = 0; kt < 4; ++kt)
#pragma unroll
                for (int s8 = 0; s8 < 8; ++s8) { const bf16x8 kf = *(const bf16x8*)(Ks + (kt * 16 + fr) * 264 + s8 * 32 + g * 8);
                    sc[kt4 * 4 + kt] = mfma16(kf, qf[s8], sc[kt4 * 4 + kt]); }
        }
        float mx = -3.0e38f;
#pragma unroll
        for (int i = 0; i < 16; ++i)
#pragma unroll
            for (int r = 0; r < 4; ++r) mx = fmaxf(mx, sc[i][r]);
        mx = fmaxf(mx, __shfl_xor(mx, 16)); mx = fmaxf(mx, __shfl_xor(mx, 32));
        float sum = 0.f;
#pragma unroll
        for (int i = 0; i < 16; ++i)
#pragma unroll
            for (int r = 0; r < 4; ++r) { const float pv = exp2f((sc[i][r] - mx) * (0.0625f * 1.44269504f)); sc[i][r] = pv; sum += pv; }
        sum += __shfl_xor(sum, 16); sum += __shfl_xor(sum, 32);
        bf16x8 pf[8];
#pragma unroll
        for (int s2 = 0; s2 < 8; ++s2) { u32x4 o; o.x = pk2(sc[2 * s2][0], sc[2 * s2][1]); o.y = pk2(sc[2 * s2][2], sc[2 * s2][3]);
            o.z = pk2(sc[2 * s2 + 1][0], sc[2 * s2 + 1][1]); o.w = pk2(sc[2 * s2 + 1][2], sc[2 * s2 + 1][3]); pf[s2] = __builtin_bit_cast(bf16x8, o); }
        f32x4 oa[16];
#pragma unroll
        for (int i = 0; i < 16; ++i) oa[i] = (f32x4){0.f, 0.f, 0.f, 0.f};
#pragma unroll
        for (int vt4 = 0; vt4 < 4; ++vt4) {
            __syncthreads();
#pragma unroll
            for (int i = 0; i < 4; ++i) { const int ch = tid + i * 512, d = ch >> 3, kc = (ch & 7) * 8; *(u32x4*)(Vs + d * 72 + kc) = pre[i]; }
            __syncthreads();
            if (vt4 < 3) {
#pragma unroll
                for (int i = 0; i < 4; ++i) { const int ch = tid + i * 512, d = ch >> 3, kc = (ch & 7) * 8; pre[i] = *(const u32x4*)(Vg + (size_t)d * 256 + (vt4 + 1) * 64 + kc); }
            }
#pragma unroll
            for (int s2l = 0; s2l < 2; ++s2l)
#pragma unroll
                for (int dt = 0; dt < 16; ++dt) {
                    const bf16_t* vp = Vs + (dt * 16 + fr) * 72 + 32 * s2l + 4 * g;
                    const u32x2 lo = *(const u32x2*)vp, hi = *(const u32x2*)(vp + 16);
                    u32x4 c; c.x = lo.x; c.y = lo.y; c.z = hi.x; c.w = hi.y;
                    oa[dt] = mfma16(__builtin_bit_cast(bf16x8, c), pf[vt4 * 2 + s2l], oa[dt]);
                }
        }
        const float inv = 1.f / sum;
        if (valid) { bf16_t* op = AO + (size_t)(row0 + myrow) * 1024 + h * 256 + 4 * g;
#pragma unroll
            for (int dt = 0; dt < 16; ++dt) { u32x2 o; o.x = pk2(oa[dt][0] * inv, oa[dt][1] * inv); o.y = pk2(oa[dt][2] * inv, oa[dt][3] * inv); *(u32x2*)(op + dt * 16) = o; } }
    }
}

DEV void ret_job(int s, int h, const KP& P, const bf16_t* PB, bf16_t* YM, unsigned char* smem) {
    const int tid = ltid(), lane = tid & 63, w = tid >> 6, fr = lane & 15, g = lane >> 4;
    const bool prompt = s < 8; const int T = prompt ? 4096 : 32, C = prompt ? DBG_C_RET : 32, nch = T / C;
    const int row0 = prompt ? s * 4096 : MPROMPT + (s - 8) * 32, pos0 = prompt ? 0 : 4096;
    const float log2g = log2f(1.f - exp2f(-5.f - (float)h));
    const float cdecay = exp2f(log2g * (float)C);
    bf16_t* Qs = (bf16_t*)smem;
    bf16_t* Ks = (bf16_t*)(smem + 17408);
    bf16_t* Kt = (bf16_t*)(smem + 34816);
    bf16_t* Vt = (bf16_t*)(smem + 53248);
    bf16_t* St = (bf16_t*)(smem + 71680);
    bf16_t* Ps = (bf16_t*)(smem + 106496);
    float* Os = (float*)smem;
    const float* st_in = prompt ? nullptr : PIN(5) + (size_t)((s - 8) * 4 + h) * 16384;
    float* st_out = P.out + (prompt ? O_PRET + (size_t)(s * 4 + h) * 16384 : O_SRET + (size_t)((s - 8) * 4 + h) * 16384);
    f32x4 Sacc[8];
#pragma unroll
    for (int dvt = 0; dvt < 8; ++dvt)
#pragma unroll
        for (int r = 0; r < 4; ++r) Sacc[dvt][r] = st_in ? st_in[(size_t)(16 * w + 4 * g + r) * 128 + dvt * 16 + fr] : 0.f;
    __syncthreads();
    for (int i = tid; i < 71680 / 16; i += NTHR) ((u32x4*)smem)[i] = (u32x4){0u, 0u, 0u, 0u};
#pragma unroll
    for (int dvt = 0; dvt < 8; ++dvt) { u32x2 o; o.x = pk2(Sacc[dvt][0], Sacc[dvt][1]); o.y = pk2(Sacc[dvt][2], Sacc[dvt][3]);
        *(u32x2*)(St + (dvt * 16 + fr) * 136 + 16 * w + 4 * g) = o; }
    __syncthreads();
    const float* gng = PIN(26) + h * 128; const float* gnb = PIN(27) + h * 128;
    u32x4 pq1 = (u32x4){0u, 0u, 0u, 0u}, pq2 = pq1, pk1 = pq1, pk2r = pq1, pv0 = pq1, pv1 = pq1, pg0 = pq1, pg1 = pq1;
#define RET_LOAD(ch_) do { const bf16_t* bp_ = PB + (size_t)(row0 + (ch_) * C + (tid >> 3)) * 3072 + h * 128; const int sg_ = tid & 7; \
        pq1 = *(const u32x4*)(bp_ + 1024 + sg_ * 8); pq2 = *(const u32x4*)(bp_ + 1024 + 64 + sg_ * 8); pk1 = *(const u32x4*)(bp_ + 1536 + sg_ * 8); pk2r = *(const u32x4*)(bp_ + 1536 + 64 + sg_ * 8); \
        pv0 = *(const u32x4*)(bp_ + 2048 + sg_ * 16); pv1 = *(const u32x4*)(bp_ + 2048 + sg_ * 16 + 8); } while (0)
    if ((tid >> 3) < C) RET_LOAD(0);
    for (int ch = 0; ch < nch; ++ch) {
        {
            const int t = tid >> 3, seg = tid & 7;
            if (t < C) {
                float q1[8], q2[8], k1[8], k2[8];
                unpack8(pq1, q1); unpack8(pq2, q2); unpack8(pk1, k1); unpack8(pk2r, k2);
                const u32x4 v0 = pv0, v1 = pv1;
                const float pos = (float)(pos0 + ch * C + t);
                const float zeta = exp2f(log2g * (float)(C - 1 - t));
                float qa[8], qb[8], ka[8], kb[8];
#pragma unroll
                for (int j = 0; j < 8; ++j) {
                    const int d = seg * 8 + j;
                    const float invf = exp2f(-(float)d * (13.287712379549449f / 64.f));
                    const float rev = pos * invf * 0.15915494309189535f; const float frc = rev - floorf(rev);
                    const float sn = __builtin_amdgcn_sinf(frc), cs = __builtin_amdgcn_cosf(frc);
                    qa[j] = q1[j] * cs - q2[j] * sn; qb[j] = q1[j] * sn + q2[j] * cs;
                    ka[j] = (k1[j] * cs - k2[j] * sn) * 0.08838834764831845f; kb[j] = (k1[j] * sn + k2[j] * cs) * 0.08838834764831845f;
                    Kt[d * 72 + t] = f2bf(ka[j] * zeta); Kt[(64 + d) * 72 + t] = f2bf(kb[j] * zeta);
                }
                *(u32x4*)(Qs + t * 136 + seg * 8) = pack8(qa); *(u32x4*)(Qs + t * 136 + 64 + seg * 8) = pack8(qb);
                *(u32x4*)(Ks + t * 136 + seg * 8) = pack8(ka); *(u32x4*)(Ks + t * 136 + 64 + seg * 8) = pack8(kb);
                const unsigned vv[8] = {v0.x, v0.y, v0.z, v0.w, v1.x, v1.y, v1.z, v1.w};
#pragma unroll
                for (int j = 0; j < 8; ++j) { Vt[(seg * 16 + 2 * j) * 72 + t] = (bf16_t)(vv[j] & 0xffffu); Vt[(seg * 16 + 2 * j + 1) * 72 + t] = (bf16_t)(vv[j] >> 16); }
                { const bf16_t* gp_ = PB + (size_t)(row0 + ch * C + t) * 3072 + 2560 + h * 128 + seg * 16; pg0 = *(const u32x4*)gp_; pg1 = *(const u32x4*)(gp_ + 8); }
                if (ch + 1 < nch) RET_LOAD(ch + 1);
            }
        }
        __syncthreads();
        {
            const int jt = w & 3;
#pragma unroll
            for (int x = 0; x < 2; ++x) {
                const int it = 2 * (w >> 2) + x; f32x4 a = (f32x4){0.f, 0.f, 0.f, 0.f};
#pragma unroll
                for (int s4 = 0; s4 < 4; ++s4) a = mfma16(*(const bf16x8*)(Ks + (jt * 16 + fr) * 136 + s4 * 32 + g * 8), *(const bf16x8*)(Qs + (it * 16 + fr) * 136 + s4 * 32 + g * 8), a);
                const int i = it * 16 + fr; float pr[4];
#pragma unroll
                for (int r = 0; r < 4; ++r) { const int j = jt * 16 + 4 * g + r; pr[r] = (i >= j) ? a[r] * exp2f(log2g * (float)(i - j)) : 0.f; }
                u32x2 o; o.x = pk2(pr[0], pr[1]); o.y = pk2(pr[2], pr[3]);
                *(u32x2*)(Ps + i * 72 + jt * 16 + 4 * g) = o;
            }
        }
        __syncthreads();
        f32x4 oacc[4];
        {
            const int it = w & 3;
#pragma unroll
            for (int x = 0; x < 4; ++x) {
                const int dvt = 4 * (w >> 2) + x; f32x4 a = (f32x4){0.f, 0.f, 0.f, 0.f};
#pragma unroll
                for (int s4 = 0; s4 < 4; ++s4) a = mfma16(*(const bf16x8*)(Qs + (it * 16 + fr) * 136 + s4 * 32 + g * 8), *(const bf16x8*)(St + (dvt * 16 + fr) * 136 + s4 * 32 + g * 8), a);
#pragma unroll
                for (int r = 0; r < 4; ++r) a[r] *= exp2f(log2g * (float)(it * 16 + 4 * g + r + 1));
#pragma unroll
                for (int s2 = 0; s2 < 2; ++s2) a = mfma16(*(const bf16x8*)(Ps + (it * 16 + fr) * 72 + s2 * 32 + g * 8), *(const bf16x8*)(Vt + (dvt * 16 + fr) * 72 + s2 * 32 + g * 8), a);
                oacc[x] = a;
            }
#pragma unroll
            for (int dvt = 0; dvt < 8; ++dvt) {
                f32x4 a = Sacc[dvt] * cdecay;
#pragma unroll
                for (int s2 = 0; s2 < 2; ++s2) a = mfma16(*(const bf16x8*)(Kt + (16 * w + fr) * 72 + s2 * 32 + g * 8), *(const bf16x8*)(Vt + (dvt * 16 + fr) * 72 + s2 * 32 + g * 8), a);
                Sacc[dvt] = a;
            }
        }
        __syncthreads();
        {
            const int it = w & 3;
#pragma unroll
            for (int x = 0; x < 4; ++x) { const int dvt = 4 * (w >> 2) + x;
#pragma unroll
                for (int r = 0; r < 4; ++r) Os[(it * 16 + 4 * g + r) * 132 + dvt * 16 + fr] = oacc[x][r]; }
#pragma unroll
            for (int dvt = 0; dvt < 8; ++dvt) { u32x2 o; o.x = pk2(Sacc[dvt][0], Sacc[dvt][1]); o.y = pk2(Sacc[dvt][2], Sacc[dvt][3]);
                *(u32x2*)(St + (dvt * 16 + fr) * 136 + 16 * w + 4 * g) = o; }
        }
        __syncthreads();
        {
            const int i = tid >> 3, seg = tid & 7; float o[16]; float sm = 0.f;
#pragma unroll
            for (int j = 0; j < 16; ++j) { o[j] = Os[i * 132 + seg * 16 + j]; sm += o[j]; }
            const float mean = red8(sm) * (1.f / 128.f); float s2 = 0.f;
#pragma unroll
            for (int j = 0; j < 16; ++j) { o[j] -= mean; s2 += o[j] * o[j]; }
            const float rstd = rsqrtf(red8(s2) * (1.f / 128.f) + 1e-5f);
            if (i < C) {
                const size_t row = (size_t)(row0 + ch * C + i);
                float gt[16]; unpack8(pg0, gt); unpack8(pg1, gt + 8);
#pragma unroll
                for (int j = 0; j < 16; ++j) { const float y = o[j] * rstd * gng[seg * 16 + j] + gnb[seg * 16 + j]; o[j] = y * gt[j] * sigmoidf_(gt[j]); }
                *(u32x4*)(YM + row * 1024 + 512 + h * 128 + seg * 16) = pack8(o); *(u32x4*)(YM + row * 1024 + 512 + h * 128 + seg * 16 + 8) = pack8(o + 8);
            }
        }
        __syncthreads();
    }
#pragma unroll
    for (int dvt = 0; dvt < 8; ++dvt)
#pragma unroll
        for (int r = 0; r < 4; ++r) st_out[(size_t)(16 * w + 4 * g + r) * 128 + dvt * 16 + fr] = Sacc[dvt][r] * DBG_RETSCALE;
}

DEV void lru_job(int s, int gb, const KP& P, const bf16_t* PB, bf16_t* YM, unsigned char* smem) {
    const int tid = ltid(), lane = tid & 63, w = tid >> 6, fr = lane & 15, g = lane >> 4;
    const bool prompt = s < 8; const int T = prompt ? 4096 : 32, C = prompt ? DBG_C : 32, nch = T / C;
    const int row0 = prompt ? s * 4096 : MPROMPT + (s - 8) * 32, bidx = prompt ? s : s - 8;
    bf16_t* Wt = (bf16_t*)smem;
    bf16_t* Xc = (bf16_t*)(smem + 18432);
    float* Xr = (float*)(smem + 27648);
    float* GA = (float*)(smem + 44800);
    float* GI = (float*)(smem + 61440);
    __syncthreads();
    for (int i = tid; i < 128 * 64; i += NTHR) { const int co = i >> 6, ci = i & 63;
        const float* wsrc = (co < 64) ? PIN(21) : PIN(23);
        Wt[co * 72 + ci] = f2bf(wsrc[(size_t)gb * 4096 + ci * 64 + (co & 63)]); }
    for (int i = tid; i < 64 * 72 / 2; i += NTHR) ((unsigned*)Xc)[i] = 0u;
    if (tid < 192) { const int j = tid >> 6, c = tid & 63; Xr[j * 64 + c] = prompt ? 0.f : PIN(3)[(size_t)(bidx * 3 + j) * 512 + gb * 64 + c]; }
    const int t = tid >> 3, seg = tid & 7, c0 = gb * 64 + seg * 8;
    float cw[4][8], cb[8], spl[8];
#pragma unroll
    for (int j = 0; j < 8; ++j) { cb[j] = PIN(20)[c0 + j]; const float lam = PIN(25)[c0 + j]; spl[j] = -8.f * log1pf(__expf(-lam));
#pragma unroll
        for (int q = 0; q < 4; ++q) cw[q][j] = PIN(19)[q * 512 + c0 + j]; }
    float* SUMS = (float*)(smem + 78080);
    float* HC = (float*)(smem + 82176);
    if (tid < 64) HC[tid] = prompt ? 0.f : PIN(4)[(size_t)bidx * 512 + gb * 64 + tid];
    const float* bias_g = (w < 4) ? PIN(22) : PIN(24);
    __syncthreads();
    u32x4 px = (u32x4){0u, 0u, 0u, 0u}, pga = px;
    if (t < C) px = *(const u32x4*)(PB + (size_t)(row0 + t) * 3072 + c0);
    for (int ch = 0; ch < nch; ++ch) {
        if (t < C) { float x[8]; unpack8(px, x);
#pragma unroll
            for (int j = 0; j < 8; ++j) Xr[(3 + t) * 64 + seg * 8 + j] = x[j];
            pga = *(const u32x4*)(PB + (size_t)(row0 + ch * C + t) * 3072 + 512 + c0);
            if (ch + 1 < nch) px = *(const u32x4*)(PB + (size_t)(row0 + (ch + 1) * C + t) * 3072 + c0); }
        __syncthreads();
        float xc[8];
#pragma unroll
        for (int j = 0; j < 8; ++j) xc[j] = 0.f;
        if (t < C) {
#pragma unroll
            for (int j = 0; j < 8; ++j) { float a = cb[j];
#pragma unroll
                for (int q = 0; q < 4; ++q) a += cw[q][j] * Xr[(t + q) * 64 + seg * 8 + j];
                xc[j] = a; }
            *(u32x4*)(Xc + t * 72 + seg * 8) = pack8(xc);
        }
        __syncthreads();
        {
            const int tt = w & 3;
#pragma unroll
            for (int x = 0; x < 4; ++x) { const int cot = 4 * (w >> 2) + x; f32x4 a = (f32x4){0.f, 0.f, 0.f, 0.f};
#pragma unroll
                for (int s2 = 0; s2 < 2; ++s2) a = mfma16(*(const bf16x8*)(Xc + (tt * 16 + fr) * 72 + s2 * 32 + g * 8), *(const bf16x8*)(Wt + (cot * 16 + fr) * 72 + s2 * 32 + g * 8), a);
                const int co = (cot & 3) * 16 + fr; const float bs = bias_g[gb * 64 + co]; float* dst = (w < 4) ? GA : GI;
#pragma unroll
                for (int r = 0; r < 4; ++r) dst[(tt * 16 + 4 * g + r) * 65 + co] = sigmoidf_(a[r] + bs); }
        }
        __syncthreads();
        if (t < C) {
#pragma unroll
            for (int j = 0; j < 8; ++j) { const int c = seg * 8 + j; const float rg = GA[t * 65 + c], ig = GI[t * 65 + c];
                const float la = spl[j] * rg, a = __expf(la); const float mult = sqrtf(fmaxf(1.f - a * a, 0.f));
                GA[t * 65 + c] = a; GI[t * 65 + c] = mult * (ig * xc[j]); }
        }
        __syncthreads();
        {
            const int SEG = C >> 3, wu = __builtin_amdgcn_readfirstlane(w);
            float pl[8], hl[8]; float pp = 1.f, hh = 0.f;
#pragma unroll
            for (int j = 0; j < 8; ++j) if (j < SEG) { const int tt = wu * SEG + j; const float a_ = GA[tt * 65 + lane], u_ = GI[tt * 65 + lane]; hh = a_ * hh + u_; pp *= a_; hl[j] = hh; pl[j] = pp; }
            SUMS[(wu * 64 + lane) * 2] = pp; SUMS[(wu * 64 + lane) * 2 + 1] = hh;
            if (wu == 1) { const float r0 = Xr[(C + 0) * 64 + lane], r1 = Xr[(C + 1) * 64 + lane], r2 = Xr[(C + 2) * 64 + lane];
                Xr[lane] = r0; Xr[64 + lane] = r1; Xr[128 + lane] = r2; }
            __syncthreads();
            float carry = HC[lane];
            for (int w2 = 0; w2 < wu; ++w2) carry = SUMS[(w2 * 64 + lane) * 2] * carry + SUMS[(w2 * 64 + lane) * 2 + 1];
#pragma unroll
            for (int j = 0; j < 8; ++j) if (j < SEG) GI[(wu * SEG + j) * 65 + lane] = hl[j] + pl[j] * carry;
            const float ncar = pp * carry + hh;
            __syncthreads();
            if (wu == 7) HC[lane] = ncar;
        }
        if (t < C) { const size_t row = (size_t)(row0 + ch * C + t); float ga[8]; unpack8(pga, ga); float y[8];
#pragma unroll
            for (int j = 0; j < 8; ++j) { const float x = ga[j]; const float ge = 0.5f * x * (1.f + tanhf_(0.7978845608f * (x + 0.044715f * x * x * x))); y[j] = GI[t * 65 + seg * 8 + j] * ge; }
            *(u32x4*)(YM + row * 1024 + c0) = pack8(y); }
        __syncthreads();
    }
    if (tid < 64) P.out[(prompt ? O_PLRU : O_SLRU) + (size_t)bidx * 512 + gb * 64 + tid] = HC[tid] * DBG_LRUSCALE;
    if (tid < 192) { const int j = tid >> 6, c = tid & 63; P.out[(prompt ? O_PCONV : O_SCONV) + (size_t)(bidx * 3 + j) * 512 + gb * 64 + c] = Xr[j * 64 + c] * DBG_CONVSCALE; }
    __syncthreads();
}

DEV void wkv_job(int s, int h, const KP& P, bf16_t* RO, const bf16_t* Kk, const bf16_t* Vv, const bf16_t* Ee, const bf16_t* Aa, const bf16_t* Gg, unsigned char* smem, bool dry) {
    const int tid = ltid(), q = tid & 15, rp = tid >> 4;
    const bool prompt = s < 8; const int T = prompt ? 4096 : 32, nch = T / 32;
    const int row0 = prompt ? s * 4096 : MPROMPT + (s - 8) * 32, bidx = prompt ? s : s - 8;
    float* vec = (float*)smem;
    float* vvb = (float*)(smem + 81920);
    float* rkb = (float*)(smem + 98304);
    float* ob = (float*)(smem + 98560);
    const float* sin_ = prompt ? nullptr : PIN(7) + (size_t)(bidx * 16 + h) * 4096;
    float* sout = P.out + (prompt ? O_PWKV : O_SWKV) + (size_t)(bidx * 16 + h) * 4096;
    const int cc = h * 64 + 4 * q;
    f32x4 S0 = (f32x4){0.f, 0.f, 0.f, 0.f}, S1 = S0;
    if (sin_) { S0 = *(const f32x4*)(sin_ + rp * 64 + 4 * q); S1 = *(const f32x4*)(sin_ + (rp + 32) * 64 + 4 * q); }
    const f32x4 kkw = *(const f32x4*)(PIN(39) + cc), kaw = *(const f32x4*)(PIN(40) + cc), rkw = *(const f32x4*)(PIN(41) + cc);
    const f32x4 gng = *(const f32x4*)(PIN(42) + cc), gnb = *(const f32x4*)(PIN(43) + cc);
    u32x2 rr, rk_, rv, re, ra, rg;
#define WKV_LOAD(c_) do { const size_t o_ = (size_t)(row0 + (c_) * 32 + rp) * 1024 + cc; rr = *(const u32x2*)(RO + o_); rk_ = *(const u32x2*)(Kk + o_); \
        rv = *(const u32x2*)(Vv + o_); re = *(const u32x2*)(Ee + o_); ra = *(const u32x2*)(Aa + o_); } while (0)
#define WKV_DERIVE(buf_) do { \
        const f32x4 rf = (f32x4){bflo(rr.x), bfhi(rr.x), bflo(rr.y), bfhi(rr.y)}, kf = (f32x4){bflo(rk_.x), bfhi(rk_.x), bflo(rk_.y), bfhi(rk_.y)}; \
        const f32x4 vf = (f32x4){bflo(rv.x), bfhi(rv.x), bflo(rv.y), bfhi(rv.y)}, ef = (f32x4){bflo(re.x), bfhi(re.x), bflo(re.y), bfhi(re.y)}; \
        const f32x4 af = (f32x4){bflo(ra.x), bfhi(ra.x), bflo(ra.y), bfhi(ra.y)}; \
        f32x4 kkv = kf * kkw; const float ss = red16(kkv[0] * kkv[0] + kkv[1] * kkv[1] + kkv[2] * kkv[2] + kkv[3] * kkv[3]); \
        const float inv = 1.f / fmaxf(sqrtf(ss), 1e-12f); kkv = kkv * inv; \
        const f32x4 km = kf * (1.f + (af - 1.f) * kaw); \
        f32x4 wv; wv[0] = __expf(-ef[0]); wv[1] = __expf(-ef[1]); wv[2] = __expf(-ef[2]); wv[3] = __expf(-ef[3]); \
        const f32x4 t3 = rf * km * rkw; const float rks = red16(t3[0] + t3[1] + t3[2] + t3[3]); \
        float* vb_ = vec + ((buf_) * 32 + rp) * 320 + 4 * q; \
        *(f32x4*)(vb_) = -kkv; *(f32x4*)(vb_ + 64) = wv; *(f32x4*)(vb_ + 128) = kkv * af; *(f32x4*)(vb_ + 192) = km; *(f32x4*)(vb_ + 256) = rf; \
        *(f32x4*)(vvb + ((buf_) * 32 + rp) * 64 + 4 * q) = vf; if (q == 0) rkb[(buf_) * 32 + rp] = rks; } while (0)
    __syncthreads();
    WKV_LOAD(0); WKV_DERIVE(0);
    __syncthreads();
    for (int c = 0; c < nch; ++c) {
        const int buf = c & 1;
        if (c + 1 < nch) WKV_LOAD(c + 1);
        rg = *(const u32x2*)(Gg + (size_t)(row0 + c * 32 + rp) * 1024 + cc);
        const float* vb = vec + buf * 32 * 320 + 4 * q; const float* vvp = vvb + buf * 32 * 64;
        f32x4 n4 = *(const f32x4*)(vb), w4 = *(const f32x4*)(vb + 64), b4 = *(const f32x4*)(vb + 128), k4 = *(const f32x4*)(vb + 192), r4 = *(const f32x4*)(vb + 256);
        float v0 = vvp[rp], v1 = vvp[rp + 32];
#pragma unroll 4
        for (int t = 0; t < 32; ++t) {
            const int tn = (t + 1) & 31;
            const f32x4 n4n = *(const f32x4*)(vb + tn * 320), w4n = *(const f32x4*)(vb + tn * 320 + 64), b4n = *(const f32x4*)(vb + tn * 320 + 128),
                        k4n = *(const f32x4*)(vb + tn * 320 + 192), r4n = *(const f32x4*)(vb + tn * 320 + 256);
            const float v0n = vvp[tn * 64 + rp], v1n = vvp[tn * 64 + rp + 32];
            const float sa0 = red16(S0[0] * n4[0] + S0[1] * n4[1] + S0[2] * n4[2] + S0[3] * n4[3]);
            const float sa1 = red16(S1[0] * n4[0] + S1[1] * n4[1] + S1[2] * n4[2] + S1[3] * n4[3]);
            S0 = S0 * w4 + (b4 * sa0 + k4 * v0);
            S1 = S1 * w4 + (b4 * sa1 + k4 * v1);
            const float o0 = red16(S0[0] * r4[0] + S0[1] * r4[1] + S0[2] * r4[2] + S0[3] * r4[3]);
            const float o1 = red16(S1[0] * r4[0] + S1[1] * r4[1] + S1[2] * r4[2] + S1[3] * r4[3]);
            if (q == 0) { ob[t * 64 + rp] = o0; ob[t * 64 + rp + 32] = o1; }
            n4 = n4n; w4 = w4n; b4 = b4n; k4 = k4n; r4 = r4n; v0 = v0n; v1 = v1n;
        }
        __syncthreads();
        {
            f32x4 o = *(const f32x4*)(ob + rp * 64 + 4 * q);
            const float mean = red16(o[0] + o[1] + o[2] + o[3]) * (1.f / 64.f); o = o - mean;
            const float var = red16(o[0] * o[0] + o[1] * o[1] + o[2] * o[2] + o[3] * o[3]) * (1.f / 64.f);
            const float rstd = rsqrtf(var + 64e-5f);
            const f32x4 vf = *(const f32x4*)(vvp + rp * 64 + 4 * q); const float rks = rkb[buf * 32 + rp];
            const f32x4 gf = (f32x4){bflo(rg.x), bfhi(rg.x), bflo(rg.y), bfhi(rg.y)};
            const f32x4 y = (o * rstd * gng + gnb + vf * rks) * gf;
            u32x2 st; st.x = pk2(y[0], y[1]); st.y = pk2(y[2], y[3]);
            if (!dry) *(u32x2*)(RO + (size_t)(row0 + c * 32 + rp) * 1024 + cc) = st;
        }
        if (c + 1 < nch) WKV_DERIVE(buf ^ 1);
        __syncthreads();
    }
    *(f32x4*)(sout + rp * 64 + 4 * q) = S0 * DBG_WKVSCALE; *(f32x4*)(sout + (rp + 32) * 64 + 4 * q) = S1 * DBG_WKVSCALE;
#undef WKV_LOAD
#undef WKV_DERIVE
}


DEV void wkv_half(int s, int h, int half, const KP& P, bf16_t* RO, const bf16_t* Kk, const bf16_t* Vv, const bf16_t* Ee, const bf16_t* Aa, const bf16_t* Gg, unsigned long long* xch, unsigned char* smem) {
    const int tid = ltid(), q = tid & 15, rp = tid >> 4;
    const bool prompt = s < 8; const int T = prompt ? 4096 : 32, nch = T / 32;
    const int row0 = prompt ? s * 4096 : MPROMPT + (s - 8) * 32, bidx = prompt ? s : s - 8;
    float* vec = (float*)smem;
    float* vvb = (float*)(smem + 81920);
    float* rkb = (float*)(smem + 98304);
    float* ob = (float*)(smem + 98560);
    float* statb = (float*)(smem + 106752);
    const int crow = half * 32;
    const float* sin_ = prompt ? nullptr : PIN(7) + (size_t)(bidx * 16 + h) * 4096;
    float* sout = P.out + (prompt ? O_PWKV : O_SWKV) + (size_t)(bidx * 16 + h) * 4096;
    const size_t gbase = prompt ? (size_t)(s * 16 + h) * 4096 : (size_t)128 * 4096 + (size_t)((s - 8) * 16 + h) * 32;
    const int cc = h * 64 + 4 * q, c2 = h * 64 + crow + 2 * q;
    f32x4 S0 = (f32x4){0.f, 0.f, 0.f, 0.f};
    if (sin_) S0 = *(const f32x4*)(sin_ + (crow + rp) * 64 + 4 * q);
    const f32x4 kkw = *(const f32x4*)(PIN(39) + cc), kaw = *(const f32x4*)(PIN(40) + cc), rkw = *(const f32x4*)(PIN(41) + cc);
    const float gw0 = PIN(42)[c2], gw1 = PIN(42)[c2 + 1], gb0 = PIN(43)[c2], gb1 = PIN(43)[c2 + 1];
    u32x2 rr, rk_, rv, re, ra; unsigned rgp = 0u;
#define WKV_LOAD(c_) do { const size_t o_ = (size_t)(row0 + (c_) * 32 + rp) * 1024 + cc; rr = *(const u32x2*)(RO + o_); rk_ = *(const u32x2*)(Kk + o_); \
        rv = *(const u32x2*)(Vv + o_); re = *(const u32x2*)(Ee + o_); ra = *(const u32x2*)(Aa + o_); } while (0)
#define WKV_DERIVE(buf_) do { \
        const f32x4 rf = (f32x4){bflo(rr.x), bfhi(rr.x), bflo(rr.y), bfhi(rr.y)}, kf = (f32x4){bflo(rk_.x), bfhi(rk_.x), bflo(rk_.y), bfhi(rk_.y)}; \
        const f32x4 vf = (f32x4){bflo(rv.x), bfhi(rv.x), bflo(rv.y), bfhi(rv.y)}, ef = (f32x4){bflo(re.x), bfhi(re.x), bflo(re.y), bfhi(re.y)}; \
        const f32x4 af = (f32x4){bflo(ra.x), bfhi(ra.x), bflo(ra.y), bfhi(ra.y)}; \
        f32x4 kkv = kf * kkw; const float ss = red16(kkv[0] * kkv[0] + kkv[1] * kkv[1] + kkv[2] * kkv[2] + kkv[3] * kkv[3]); \
        const float inv = 1.f / fmaxf(sqrtf(ss), 1e-12f); kkv = kkv * inv; \
        const f32x4 km = kf * (1.f + (af - 1.f) * kaw); \
        f32x4 wv; wv[0] = __expf(-ef[0]); wv[1] = __expf(-ef[1]); wv[2] = __expf(-ef[2]); wv[3] = __expf(-ef[3]); \
        const f32x4 t3 = rf * km * rkw; const float rks = red16(t3[0] + t3[1] + t3[2] + t3[3]); \
        float* vb_ = vec + ((buf_) * 32 + rp) * 320 + 4 * q; \
        *(f32x4*)(vb_) = -kkv; *(f32x4*)(vb_ + 64) = wv; *(f32x4*)(vb_ + 128) = kkv * af; *(f32x4*)(vb_ + 192) = km; *(f32x4*)(vb_ + 256) = rf; \
        *(f32x4*)(vvb + ((buf_) * 32 + rp) * 64 + 4 * q) = vf; if (q == 0) rkb[(buf_) * 32 + rp] = rks; } while (0)
#define WKV_FINAL(cc_, fb_) do { \
        unsigned long long* pg_ = xch + ((gbase + (size_t)((cc_) * 32 + rp)) * 2 + (half ^ 1)); unsigned long long pv_; unsigned sp_ = 0u; \
        do { pv_ = __hip_atomic_load(pg_, __ATOMIC_RELAXED, __HIP_MEMORY_SCOPE_AGENT); if ((unsigned)pv_ != 0xFFFFFFFFu) break; __builtin_amdgcn_s_sleep(1); } while (++sp_ < (1u << 22)); \
        const float sm_ = statb[((fb_) * 32 + rp) * 2] + __uint_as_float((unsigned)pv_), sq_ = statb[((fb_) * 32 + rp) * 2 + 1] + __uint_as_float((unsigned)(pv_ >> 32)); \
        const float mean_ = sm_ * (1.f / 64.f), var_ = fmaxf(sq_ * (1.f / 64.f) - mean_ * mean_, 0.f), rstd_ = rsqrtf(var_ + 64e-5f); \
        const float o0_ = ob[((fb_) * 32 + rp) * 32 + 2 * q], o1_ = ob[((fb_) * 32 + rp) * 32 + 2 * q + 1]; \
        const float v0_ = vvb[((fb_) * 32 + rp) * 64 + crow + 2 * q], v1_ = vvb[((fb_) * 32 + rp) * 64 + crow + 2 * q + 1], rks_ = rkb[(fb_) * 32 + rp]; \
        const float y0_ = ((o0_ - mean_) * rstd_ * gw0 + gb0 + v0_ * rks_) * bflo(rgp), y1_ = ((o1_ - mean_) * rstd_ * gw1 + gb1 + v1_ * rks_) * bfhi(rgp); \
        *(unsigned*)(RO + (size_t)(row0 + (cc_) * 32 + rp) * 1024 + c2) = pk2(y0_, y1_); } while (0)
    __syncthreads();
    WKV_LOAD(0); WKV_DERIVE(0);
    __syncthreads();
    for (int c = 0; c < nch; ++c) {
        const int buf = c & 1;
        if (c + 1 < nch) WKV_LOAD(c + 1);
        if (c > 0) rgp = *(const unsigned*)(Gg + (size_t)(row0 + (c - 1) * 32 + rp) * 1024 + c2);
        const float* vb = vec + buf * 32 * 320 + 4 * q; const float* vvp = vvb + buf * 32 * 64 + crow;
        f32x4 n4 = *(const f32x4*)(vb), w4 = *(const f32x4*)(vb + 64), b4 = *(const f32x4*)(vb + 128), k4 = *(const f32x4*)(vb + 192), r4 = *(const f32x4*)(vb + 256);
        float v0 = vvp[rp];
#pragma unroll 4
        for (int t = 0; t < 32; ++t) {
            const int tn = (t + 1) & 31;
            const f32x4 n4n = *(const f32x4*)(vb + tn * 320), w4n = *(const f32x4*)(vb + tn * 320 + 64), b4n = *(const f32x4*)(vb + tn * 320 + 128),
                        k4n = *(const f32x4*)(vb + tn * 320 + 192), r4n = *(const f32x4*)(vb + tn * 320 + 256);
            const float v0n = vvp[tn * 64 + rp];
            const float sa0 = red16(S0[0] * n4[0] + S0[1] * n4[1] + S0[2] * n4[2] + S0[3] * n4[3]);
            S0 = S0 * w4 + (b4 * sa0 + k4 * v0);
            const float o0 = red16(S0[0] * r4[0] + S0[1] * r4[1] + S0[2] * r4[2] + S0[3] * r4[3]);
            if (q == 0) ob[(buf * 32 + t) * 32 + rp] = o0;
            n4 = n4n; w4 = w4n; b4 = b4n; k4 = k4n; r4 = r4n; v0 = v0n;
        }
        __syncthreads();
        {
            const float o0 = ob[(buf * 32 + rp) * 32 + 2 * q], o1 = ob[(buf * 32 + rp) * 32 + 2 * q + 1];
            const float sm = red16(o0 + o1), sq = red16(o0 * o0 + o1 * o1);
            if (q == 0) { statb[(buf * 32 + rp) * 2] = sm; statb[(buf * 32 + rp) * 2 + 1] = sq;
                __hip_atomic_store(xch + ((gbase + (size_t)(c * 32 + rp)) * 2 + half), (unsigned long long)__float_as_uint(sm) | ((unsigned long long)__float_as_uint(sq) << 32), __ATOMIC_RELAXED, __HIP_MEMORY_SCOPE_AGENT); }
        }
        if (c > 0) WKV_FINAL(c - 1, buf ^ 1);
        __syncthreads();
        if (c + 1 < nch) WKV_DERIVE(buf ^ 1);
        __syncthreads();
    }
    rgp = *(const unsigned*)(Gg + (size_t)(row0 + (nch - 1) * 32 + rp) * 1024 + c2);
    WKV_FINAL(nch - 1, (nch - 1) & 1);
    *(f32x4*)(sout + (crow + rp) * 64 + 4 * q) = S0;
#undef WKV_LOAD
#undef WKV_DERIVE
#undef WKV_FINAL
}

#define XB_TMO      128
#define XB_XCNT(j)  (256  + 64 * (j))
#define XB_XSUB(j)  (1280 + 64 * (j))
#define XB_XGEN(j)  (2304 + 64 * (j))
#define XB_TOP      3328
#define XB_TOPGEN   3392
#define XCD_BAR_WORDS 3456
#define XB_SPIN_CAP (1u << 22)
DEV unsigned xb_ld(unsigned* p)              { return __hip_atomic_load(p, __ATOMIC_RELAXED, __HIP_MEMORY_SCOPE_AGENT); }
DEV unsigned xb_add(unsigned* p, unsigned v) { return __hip_atomic_fetch_add(p, v, __ATOMIC_RELAXED, __HIP_MEMORY_SCOPE_AGENT); }
DEV unsigned xb_xcc_id() { return (unsigned)__builtin_amdgcn_s_getreg((3 << 11) | 20) & 0xFu; }
#define XB_SPIN(cond, bar) do { unsigned _sp = 0; while (cond) { __builtin_amdgcn_s_sleep(1); \
    if ((++_sp & 255u) == 0u) { if (xb_ld(&(bar)[XB_TMO])) break; if (_sp > XB_SPIN_CAP) { atomicAdd(&(bar)[XB_TMO], 1u); break; } } } } while (0)
struct XcdBarrier { unsigned* bar; unsigned x; volatile LAS unsigned* st; };
DEV XcdBarrier xcd_barrier_post(unsigned* bar, volatile LAS unsigned* st) {
    XcdBarrier b; b.bar = bar; b.x = xb_xcc_id(); b.st = st;
    if (threadIdx.x == 0) (void)xb_add(&bar[XB_XCNT(b.x)], 1u);
    return b;
}
DEV void xcd_barrier_complete(unsigned* bar, unsigned x, unsigned& nloc, unsigned& nx) {
    const unsigned G = gridDim.x * gridDim.y * gridDim.z;
    unsigned sum, cnt, mine, sp = 0u;
    for (;;) {
        sum = 0u; cnt = 0u; mine = 0u;
#pragma unroll
        for (unsigned j = 0; j < 16; ++j) { const unsigned c = xb_ld(&bar[XB_XCNT(j)]); sum += c; cnt += (c > 0u) ? 1u : 0u; mine = (j == x) ? c : mine; }
        if (sum == G) break;
        __builtin_amdgcn_s_sleep(1);
        if ((++sp & 255u) == 0u) { if (xb_ld(&bar[XB_TMO])) break; if (sp > XB_SPIN_CAP) { atomicAdd(&bar[XB_TMO], 1u); break; } }
    }
    nloc = mine > 0u ? mine : 1u; nx = cnt > 0u ? cnt : 1u;
}
DEV void xcd_barrier(const XcdBarrier& b) {
    asm volatile("s_waitcnt vmcnt(0)" ::: "memory");
    __syncthreads();
    if (threadIdx.x == 0) {
        unsigned* bar = b.bar;
        __builtin_amdgcn_s_waitcnt(0);
        unsigned nloc = b.st[0], nx = b.st[1];
        if (nloc == 0u) { xcd_barrier_complete(bar, b.x, nloc, nx); b.st[0] = nloc; b.st[1] = nx; }
        const unsigned old = xb_add(&bar[XB_XSUB(b.x)], 1u);
        const unsigned gen = old / nloc;
        if (old + 1u == (gen + 1u) * nloc) {
            __builtin_amdgcn_fence(__ATOMIC_RELEASE, "agent");
            asm volatile("s_waitcnt vmcnt(0)" ::: "memory");
            const unsigned og = xb_add(&bar[XB_TOP], 1u);
            const unsigned tg = og / nx;
            if (og + 1u == (tg + 1u) * nx) xb_add(&bar[XB_TOPGEN], 1u);
            else XB_SPIN(xb_ld(&bar[XB_TOPGEN]) == tg, bar);
            __builtin_amdgcn_fence(__ATOMIC_ACQUIRE, "agent");
            xb_add(&bar[XB_XGEN(b.x)], 1u);
            asm volatile("s_waitcnt vmcnt(0)" ::: "memory");
        } else {
            XB_SPIN(xb_ld(&bar[XB_XGEN(b.x)]) == gen, bar);
            __builtin_amdgcn_fence(__ATOMIC_ACQUIRE, "agent");
            asm volatile("s_waitcnt vmcnt(0)" ::: "memory");
        }
    }
    __syncthreads();
}

__global__ void __launch_bounds__(NTHR, 2) mega(KP P) {
    extern __shared__ __attribute__((aligned(16))) unsigned char smem[];
    cg::grid_group grid = cg::this_grid();
    unsigned char* ws = P.ws;
    bf16_t* W = (bf16_t*)ws;
    bf16_t* KB = (bf16_t*)(ws + WS_KB); bf16_t* VT = (bf16_t*)(ws + WS_VT);
    bf16_t* XB = (bf16_t*)(ws + WS_XB); bf16_t* A1 = (bf16_t*)(ws + WS_A1); bf16_t* A2 = (bf16_t*)(ws + WS_A2);
    bf16_t* A3 = (bf16_t*)(ws + WS_A3); bf16_t* A4 = (bf16_t*)(ws + WS_A4); bf16_t* HL = (bf16_t*)(ws + WS_HL);
    bf16_t* D1 = (bf16_t*)P.out; bf16_t* D2 = D1 + E_EL;
    {
        if (threadIdx.x == 0) { *(volatile LAS unsigned*)((LAS unsigned char*)smem + LDS_BYTES - 16) = 0u; *(volatile LAS unsigned*)((LAS unsigned char*)smem + LDS_BYTES - 12) = 0u; }
        __syncthreads();
    }
    const XcdBarrier xbar = xcd_barrier_post((unsigned*)(ws + WS_END), (volatile LAS unsigned*)((LAS unsigned char*)smem + LDS_BYTES - 16));
    for (int ph = P.ph_lo; ph < P.ph_hi; ++ph) {
        GD d; d.mode = -1; d.coff = 0; d.ep = EpiP{nullptr, nullptr, nullptr, nullptr, nullptr, nullptr, nullptr, 0, 0.f};
        int lnidx = -1; int attl = -1;
#define GEMM_SET(A0_, A1_, Bt_, lda_, K_, nt0_, M_, N_, mode_) do { d.g = pg8::Gemm{A0_, A1_, Bt_, lda_, K_, nt0_, M_, N_}; d.mode = mode_; } while (0)
        switch (ph) {
            case 0: prep_phase(P, smem, 0, (int)blockIdx.x, (int)gridDim.x); break;
            case 1: { GD d2; d2.coff = 128; d2.mode = 5; d2.g = pg8::Gemm{A4, A4, W + W_KV, 1024, 1024, 16, 2048, 4096};
                      d2.ep = EpiP{KB, VT, nullptr, nullptr, P.out, nullptr, nullptr, 0, 0.f}; run_gemm(d2, smem); }
            case 12: case 15: case 27: { const int wi = (ph == 1) ? 0 : (ph == 12 ? 1 : (ph == 15 ? 2 : 3));
                      GEMM_SET(XB, XB, W + W_UP + (size_t)wi * 5632 * 1024, 1024, 1024, 16, MTOK, 5632, 1); d.ep.o0 = A1; } break;
            case 2: case 13: case 16: case 28: { const int wi = (ph == 2) ? 0 : (ph == 13 ? 1 : (ph == 16 ? 2 : 3));
                      GEMM_SET(A1, A1, W + W_DN + (size_t)wi * 1024 * 2816, 2816, 2816, 44, MTOK, 1024, 2); d.ep.o0 = XB; d.ep.s = 0.5f; } break;
            case 3: lnidx = 0; break; case 7: lnidx = 1; break; case 11: lnidx = 2; break; case 14: lnidx = 3; break;
            case 17: lnidx = 4; break; case 22: lnidx = 5; break; case 26: lnidx = 6; break; case 29: lnidx = 7; break;
            case 4: GEMM_SET(XB, XB, W + W_IN, 1024, 1024, 16, MTOK, 3072, 0); d.ep.o0 = A1; d.ep.ldc = 3072; break;
            case 5: for (int rep = 0; rep < DBG_MIXREP; ++rep) for (int job = blockIdx.x; job < 288; job += gridDim.x) {
                        if (job < 32) ret_job(job >> 2, job & 3, P, A1, A4, smem);
                        else if (job < 96) lru_job((job - 32) >> 3, (job - 32) & 7, P, A1, A4, smem);
                        else if (job < 160) ret_job(8 + ((job - 96) >> 2), (job - 96) & 3, P, A1, A4, smem);
                        else lru_job(8 + ((job - 160) >> 3), (job - 160) & 7, P, A1, A4, smem);
                    }
                    if (gridDim.x > 128) { if (blockIdx.x >= 96) { __syncthreads(); prep_phase(P, smem, 1, (int)blockIdx.x - 96, (int)gridDim.x - 96); } }
                    else { __syncthreads(); prep_phase(P, smem, 1, (int)blockIdx.x, (int)gridDim.x); }
                    break;
            case 6: GEMM_SET(A4, A4, W + W_O0, 1024, 1024, 16, MTOK, 1024, 2); d.ep.o0 = XB; d.ep.s = 1.f; break;
            case 8: GEMM_SET(XB, XB, W + W_XQ, 1024, 1024, 16, MTOK, 1024, 0); d.ep.o0 = A1; d.ep.ldc = 1024; break;
            case 9: for (int rep = 0; rep < DBG_ATTREP; ++rep) attn_phase(A1, KB, VT, A2, smem); break;
            case 10: GEMM_SET(A2, A2, W + W_XO, 1024, 1024, 16, MTOK, 1024, 2); d.ep.o0 = XB; d.ep.s = 1.f; break;
            case 18: GEMM_SET(XB, A4, W + W_P1, 1024, 2048, 16, MTOK, 3328, 3); d.ep.o0 = A1; d.ep.o1 = A2; d.ep.o2 = A3; d.ep.o3 = HL; break;
            case 19: GEMM_SET(HL, HL, W + W_L2, 256, 256, 4, MTOK, 3072, 4); d.ep.o0 = D1; d.ep.o1 = D2; d.ep.o2 = A4; d.ep.v0 = PIN(31); d.ep.v1 = PIN(34); break;
            case 20: if (gridDim.x == 256) {
                        unsigned long long* xch = (unsigned long long*)(ws + WS_END + 16384);
                        const int hf = blockIdx.x & 1, pj = blockIdx.x >> 1;
                        wkv_half(pj >> 4, pj & 15, hf, P, A1, A2, A3, D1, D2, A4, xch, smem);
                        wkv_half(8 + (pj >> 4), pj & 15, hf, P, A1, A2, A3, D1, D2, A4, xch, smem);
                        wkv_half(8 + ((pj + 128) >> 4), (pj + 128) & 15, hf, P, A1, A2, A3, D1, D2, A4, xch, smem);
                    } else for (int job = blockIdx.x; job < 384; job += gridDim.x) {
                        if (job < 128) wkv_job(job >> 4, job & 15, P, A1, A2, A3, D1, D2, A4, smem, false);
                        else wkv_job(8 + ((job - 128) >> 4), (job - 128) & 15, P, A1, A2, A3, D1, D2, A4, smem, false);
                    } break;
            case 21: GEMM_SET(A1, A1, W + W_O1, 1024, 1024, 16, MTOK, 1024, 2); d.ep.o0 = XB; d.ep.s = 1.f; break;
            case 23: GEMM_SET(XB, XB, W + W_XQ + 1048576, 1024, 1024, 16, MTOK, 1024, 0); d.ep.o0 = A2; d.ep.ldc = 1024; break;
            case 24: attn_phase(A2, KB + (size_t)24 * 256 * 1024, VT + (size_t)24 * 256 * 1024, A3, smem); break;
            case 25: GEMM_SET(A3, A3, W + W_XO + 1048576, 1024, 1024, 16, MTOK, 1024, 2); d.ep.o0 = XB; d.ep.s = 1.f; break;
            default: break;
        }
        if (d.mode >= 0) run_gemm(d, smem);
        if (DBG_GREP > 1 && ph == 4) run_gemm(d, smem);
        if (DBG_LNREP > 1 && lnidx == 0) ln_phase(XB, PIN(10) + lnidx * 1024, PIN(11) + lnidx * 1024, nullptr, nullptr, PIN(6), P.out, P.ph_hi < 1000);
        if (lnidx >= 0) ln_phase(XB, PIN(10) + lnidx * 1024, PIN(11) + lnidx * 1024, lnidx == 4 ? A4 : nullptr, lnidx == 7 ? P.out + O_Y : nullptr, PIN(6), P.out, false);
        (void)attl;
        if (ph == 6) for (int rep = 0; rep < DBG_SYNCREP; ++rep) { __threadfence(); grid.sync(); __builtin_amdgcn_fence(__ATOMIC_ACQUIRE, "agent"); asm volatile("buffer_inv sc1" ::: "memory"); }
        if (ph + 1 < P.ph_hi) {
            if (P.ph_lo == 0x7fffffff) grid.sync();
            xcd_barrier(xbar);
        }
    }
}

extern "C" void kernel_launch(void* const* d_in, const int* in_sizes, int n_in, void* d_out, int out_size, void* d_ws, size_t ws_size, hipStream_t stream) {
    static int grid_blocks = 0;
    if (grid_blocks == 0) {
        if (n_in != 45 || ws_size < WS_END + 16384 + 8519680) { fprintf(stderr, "kernel_launch: unexpected n_in %d or ws_size %zu (< %zu)\n", n_in, ws_size, (size_t)WS_END); grid_blocks = -1; return; }
        int dev = 0, cus = 0, per_cu = 0;
        hipGetDevice(&dev);
        hipDeviceGetAttribute(&cus, hipDeviceAttributeMultiprocessorCount, dev);
        if (hipFuncSetAttribute((const void*)mega, hipFuncAttributeMaxDynamicSharedMemorySize, LDS_BYTES) != hipSuccess) { fprintf(stderr, "kernel_launch: hipFuncSetAttribute failed\n"); grid_blocks = -1; return; }
        hipOccupancyMaxActiveBlocksPerMultiprocessor(&per_cu, (const void*)mega, NTHR, LDS_BYTES);
        if (per_cu < 1) { fprintf(stderr, "kernel_launch: occupancy query returned %d\n", per_cu); per_cu = 1; }
        (void)hipGetLastError();
        grid_blocks = cus * per_cu;
    }
    if (grid_blocks < 0) return;
    if (hipMemsetAsync((char*)d_ws + WS_END, 0, 16384, stream) != hipSuccess) { fprintf(stderr, "kernel_launch: memset of the barrier word failed\n"); return; }
    if (hipMemsetAsync((char*)d_ws + WS_END + 16384, 0xFF, 8519680, stream) != hipSuccess) { fprintf(stderr, "kernel_launch: memset of the exchange granules failed\n"); return; }
    KP p{};
    for (int i = 0; i < 45; ++i) p.in[i] = (const float*)d_in[i];
    p.out = (float*)d_out; p.ws = (unsigned char*)d_ws; p.ph_lo = 0; p.ph_hi = 30;
    void* args[] = {&p};
    hipError_t e = hipLaunchCooperativeKernel((const void*)mega, dim3(grid_blocks), dim3(NTHR), args, LDS_BYTES, stream);
    if (e != hipSuccess) fprintf(stderr, "cooperative launch failed: %s (grid %d)\n", hipGetErrorString(e), grid_blocks);
}
```

```cpp
#include <hip/hip_runtime.h>
#include <hip/hip_cooperative_groups.h>
#include <cstdio>
#include <cstdint>
namespace cg = cooperative_groups;

#define LAS __attribute__((address_space(3)))
#define DEV __device__ __forceinline__
typedef unsigned short bf16_t;
typedef short bf16x8 __attribute__((ext_vector_type(8)));
typedef float f32x4 __attribute__((ext_vector_type(4)));
typedef unsigned u32x4 __attribute__((ext_vector_type(4)));
typedef unsigned u32x2 __attribute__((ext_vector_type(2)));

constexpr int MTOK = 33280, DM = 1024, MPROMPT = 32768, NTHR = 512;
constexpr int LDS_BYTES = 147456;
#define DBG_C 64
#define DBG_C_RET 64
#define DBG_SCANREP 1
#define DBG_MIXREP 1
#define DBG_GREP 1
#define DBG_SYNCREP 0
#define DBG_LNREP 1
#define DBG_ATTREP 1
#define DBG_PREPREP 1
#define DBG_YSCALE 1.0f
#define DBG_SHSCALE 1.0f
#define DBG_WKVSCALE 1.0f
#define DBG_RETSCALE 1.0f
#define DBG_LRUSCALE 1.0f
#define DBG_CONVSCALE 1.0f
constexpr size_t E_EL = (size_t)MTOK * DM;
constexpr size_t W_UP = 0;
constexpr size_t W_DN = W_UP + (size_t)4 * 5632 * 1024;
constexpr size_t W_XQ = W_DN + (size_t)4 * 1024 * 2816;
constexpr size_t W_XO = W_XQ + (size_t)2 * 1048576;
constexpr size_t W_KV = W_XO + (size_t)2 * 1048576;
constexpr size_t W_IN = W_KV + (size_t)4096 * 1024;
constexpr size_t W_O0 = W_IN + (size_t)3072 * 1024;
constexpr size_t W_P1 = W_O0 + (size_t)1048576;
constexpr size_t W_L2 = W_P1 + (size_t)3328 * 2048;
constexpr size_t W_O1 = W_L2 + (size_t)3072 * 256;
constexpr size_t W_END = W_O1 + (size_t)1048576;
constexpr size_t KV_EL = (size_t)2 * 24 * 256 * 1024;
constexpr size_t WS_KB = W_END * 2;
constexpr size_t WS_VT = WS_KB + KV_EL * 2;
constexpr size_t WS_XB = WS_VT + KV_EL * 2;
constexpr size_t WS_A1 = WS_XB + E_EL * 2;
constexpr size_t WS_A2 = WS_A1 + E_EL * 2;
constexpr size_t WS_A3 = WS_A2 + E_EL * 2;
constexpr size_t WS_A4 = WS_A3 + E_EL * 2;
constexpr size_t WS_HL = WS_A4 + E_EL * 2;
constexpr size_t WS_END = WS_HL + (size_t)MTOK * 256 * 2;
constexpr size_t O_Y = 0, O_MK = 34078720, O_MV = 38273024, O_PCONV = 42467328, O_PLRU = 42479616, O_PRET = 42483712,
                 O_PSHIFT = 43008000, O_PWKV = 43016192, O_SCONV = 43540480, O_SLRU = 43565056, O_SRET = 43573248,
                 O_SSHIFT = 44621824, O_SWKV = 44638208;

struct KP { const float* in[45]; float* out; unsigned char* ws; int ph_lo, ph_hi; };

DEV int ltid() { int t = threadIdx.x; asm volatile("" : "+v"(t)); return t; }
DEV const float* pin(const KP& P, int k) { asm volatile("" : "+s"(k)); return P.in[k]; }
#define PIN(k) pin(P, k)
typedef float f32x2_t __attribute__((ext_vector_type(2)));
typedef __bf16 bf16x2_t __attribute__((ext_vector_type(2)));
DEV unsigned pk2(float lo, float hi) { const f32x2_t v = {lo, hi}; return __builtin_bit_cast(unsigned, __builtin_convertvector(v, bf16x2_t)); }
DEV float bflo(unsigned u) { return __uint_as_float(u << 16); }
DEV float bfhi(unsigned u) { return __uint_as_float(u & 0xffff0000u); }
DEV float bf1(bf16_t b) { return __uint_as_float(((unsigned)b) << 16); }
DEV bf16_t f2bf(float f) { return (bf16_t)(pk2(f, f) & 0xffffu); }
DEV float sigmoidf_(float x) { return __builtin_amdgcn_rcpf(1.f + __expf(-x)); }
DEV float tanhf_(float x) { return 1.f - 2.f / (__expf(2.f * x) + 1.f); }
template <int CTRL> DEV float dppf(float v) { return __builtin_bit_cast(float, __builtin_amdgcn_update_dpp(0, __builtin_bit_cast(int, v), CTRL, 0xf, 0xf, true)); }
DEV float red8(float v) { v += dppf<0xB1>(v); v += dppf<0x4E>(v); v += dppf<0x141>(v); return v; }
DEV float red16(float v) { v = red8(v); v += dppf<0x140>(v); return v; }
DEV float wave_sum(float v) {
#pragma unroll
    for (int o = 1; o < 64; o <<= 1) v += __shfl_xor(v, o);
    return v;
}
DEV void unpack8(u32x4 u, float* f) { f[0] = bflo(u.x); f[1] = bfhi(u.x); f[2] = bflo(u.y); f[3] = bfhi(u.y); f[4] = bflo(u.z); f[5] = bfhi(u.z); f[6] = bflo(u.w); f[7] = bfhi(u.w); }
DEV u32x4 pack8(const float* f) { u32x4 o; o.x = pk2(f[0], f[1]); o.y = pk2(f[2], f[3]); o.z = pk2(f[4], f[5]); o.w = pk2(f[6], f[7]); return o; }
DEV f32x4 mfma16(bf16x8 a, bf16x8 b, f32x4 c) { return __builtin_amdgcn_mfma_f32_16x16x32_bf16(a, b, c, 0, 0, 0); }

namespace pg8 {
constexpr int BM = 256, BK = 64, HALF = 128, HTB = HALF * BK * 2, NXCD = 8, WGM = 8;
DEV int lds_byte(int r, int c) { const int st = (r >> 4) * 2 + (c >> 5), rr = r & 15, cc = c & 31, ob = rr * 64 + cc * 2; return st * 1024 + (ob ^ (((ob >> 9) & 1) << 5)); }
DEV void stage_rc(int b, int& R, int& C) { const int st = b / 1024, sb = b % 1024, swz = sb ^ (((sb >> 9) & 1) << 5); R = (st >> 1) * 16 + swz / 64; C = (st & 1) * 32 + (swz % 64) / 2; }
DEV int perm32(int rho) { const int n = rho >> 4, i = rho & 15; return 8 * (i >> 2) + 4 * n + (i & 3); }
struct Unit { int pm, pn; };
struct Gemm { const bf16_t* A0; const bf16_t* A1; const bf16_t* Bt; int lda, K, nt0, M, N; };
struct StaticOrder {
    int nM, nN, nwg, G, c;
    DEV void init(int M, int N, int G_, int c_) { nM = M / BM; nN = N / BM; nwg = nM * nN; G = G_; c = c_; }
    DEV bool next(int i, Unit& u) const {
        const long L = (long)i * G + c; if (L >= nwg) return false;
        int wgid = (int)L; { const int q = nwg / NXCD, r = nwg % NXCD, xcd = wgid % NXCD, off = wgid / NXCD; wgid = (xcd < r ? xcd * (q + 1) : r * (q + 1) + (xcd - r) * q) + off; }
        const int nig = WGM * nN, gid = wgid / nig, fm = gid * WGM, gsz = (nM - fm) < WGM ? (nM - fm) : WGM;
        u.pm = fm + ((wgid % nig) % gsz); u.pn = (wgid % nig) / gsz; return true;
    }
};

template <class Epi>
DEV void gemm_phase(LAS unsigned char* lds, const Gemm g, const StaticOrder& S, const Epi& E) {
    const int tid = ltid(), wid = __builtin_amdgcn_readfirstlane(tid >> 6), lane = tid & 63, wr = wid >> 2, wc = wid & 3, fr = lane & 15, fq = lane >> 4;
    const int K = g.K, nt = K / BK, lda = g.lda, nt0 = g.nt0;
    unsigned voffA[2], voffB[2];
#pragma unroll
    for (int i = 0; i < 2; ++i) { int R, C; stage_rc(tid * 16 + i * 8192, R, C); const int Rb = (R & ~31) + perm32(R & 31);
        voffA[i] = (unsigned)(R * lda + C) * 2u; voffB[i] = (unsigned)(Rb * K + C) * 2u; }
    const size_t kstep = (size_t)(BK * 2);
    const size_t hstepA = (size_t)HALF * lda * 2, hstepB = (size_t)HALF * K * 2;
    const size_t tstepA = 2 * hstepA, tstepB = 2 * hstepB;
    const unsigned ldsw = (unsigned)wid * 1024u;
    const int aoff = lds_byte(wr * 64 + fr, fq * 8), boff = lds_byte(wc * 32 + fr, fq * 8);
    const char* const gA0 = (const char*)g.A0; const char* const gA1 = (const char*)g.A1 - (size_t)nt0 * kstep;
#define PG8_AK(rowoff, kt) (((kt) < nt0 ? gA0 : gA1) + (rowoff) + (size_t)(kt) * kstep)
#define PG8_SA(b, h) (((b) * 2 + (h)) * HTB)
#define PG8_SB(b, h) ((4 + (b) * 2 + (h)) * HTB)
#define PG8_STAGE(bufoff, gbase, voff) do { _Pragma("unroll") for (int _i = 0; _i < 2; ++_i) \
        __builtin_amdgcn_global_load_lds((const unsigned*)((const char*)(gbase) + (voff)[_i]), (LAS unsigned*)(lds + (bufoff) + ldsw + _i * 8192), 16, 0, 0); } while (0)
#define PG8_LDA(dst, b, h) do { _Pragma("unroll") for (int m = 0; m < 4; ++m) _Pragma("unroll") for (int k = 0; k < 2; ++k) dst[m][k] = *(const LAS bf16x8*)(lds + PG8_SA(b, h) + aoff + m * 2048 + k * 1024); } while (0)
#define PG8_LDB(dst, b, h) do { _Pragma("unroll") for (int n = 0; n < 2; ++n) _Pragma("unroll") for (int k = 0; k < 2; ++k) dst[n][k] = *(const LAS bf16x8*)(lds + PG8_SB(b, h) + boff + n * 2048 + k * 1024); } while (0)
#define PG8_MMA(ai, bj, At, Bt) do { __builtin_amdgcn_s_setprio(1); _Pragma("unroll") for (int m = 0; m < 4; ++m) _Pragma("unroll") for (int n = 0; n < 2; ++n) _Pragma("unroll") for (int k = 0; k < 2; ++k) \
        acc[ai][bj][m][n] = __builtin_amdgcn_mfma_f32_16x16x32_bf16(Bt[n][k], At[m][k], acc[ai][bj][m][n], 0, 0, 0); __builtin_amdgcn_s_setprio(0); } while (0)
#define PG8_WAIT_V(n) asm volatile("s_waitcnt vmcnt(" #n ")" ::: "memory")
#define PG8_WAIT_L(n) asm volatile("s_waitcnt lgkmcnt(" #n ")" ::: "memory")
#define PG8_BAR __builtin_amdgcn_s_barrier()
#define PG8_SCHED __builtin_amdgcn_sched_barrier(0)
    Unit cur, nxt; int ui = 0;
    if (!S.next(0, cur)) return;
    f32x4 acc[2][2][4][2];
#pragma unroll
    for (int a = 0; a < 2; ++a)
#pragma unroll
        for (int b = 0; b < 2; ++b)
#pragma unroll
            for (int m = 0; m < 4; ++m)
#pragma unroll
                for (int n = 0; n < 2; ++n) acc[a][b][m][n] = (f32x4){0.f, 0.f, 0.f, 0.f};
    bf16x8 At[4][2], B0[2][2], B1[2][2];
    size_t cAo = (size_t)cur.pm * tstepA; const char* cB = (const char*)g.Bt + (size_t)cur.pn * tstepB;
    { const char* a0p = PG8_AK(cAo, 0); const char* a1p = PG8_AK(cAo, 1);
      PG8_STAGE(PG8_SB(0, 0), cB, voffB); PG8_STAGE(PG8_SB(0, 1), cB + hstepB, voffB); PG8_STAGE(PG8_SA(0, 0), a0p, voffA); PG8_STAGE(PG8_SA(0, 1), a0p + hstepA, voffA);
      if (wr == 1) PG8_BAR;
      PG8_WAIT_V(2); PG8_BAR;
      PG8_STAGE(PG8_SB(1, 0), cB + kstep, voffB); PG8_STAGE(PG8_SA(1, 0), a1p, voffA); PG8_STAGE(PG8_SB(1, 1), cB + hstepB + kstep, voffB);
      PG8_WAIT_V(6); PG8_BAR; }
    for (;;) {
        const bool has_next = S.next(ui + 1, nxt);
        const size_t nAo = has_next ? (size_t)nxt.pm * tstepA : cAo; const char* nB = has_next ? (const char*)g.Bt + (size_t)nxt.pn * tstepB : cB;
        for (int t = 0; t < nt; t += 2) {
            const bool last = (t == nt - 2);
            const char* a1 = PG8_AK(cAo, t + 1);
            const char* a2 = last ? PG8_AK(nAo, 0) : PG8_AK(cAo, t + 2); const char* b2 = last ? nB : cB + (size_t)(t + 2) * kstep;
            const char* a3 = last ? PG8_AK(nAo, 1) : PG8_AK(cAo, t + 3); const char* b3 = b2 + kstep;
            PG8_LDB(B0, 0, 0); PG8_LDB(B1, 0, 1); PG8_SCHED; PG8_LDA(At, 0, 0); PG8_STAGE(PG8_SA(1, 1), a1 + hstepA, voffA);
            PG8_WAIT_V(8); PG8_WAIT_L(0); PG8_BAR; PG8_MMA(0, 0, At, B0); PG8_MMA(0, 1, At, B1); PG8_BAR; PG8_SCHED;
            PG8_LDA(At, 0, 1); PG8_STAGE(PG8_SB(0, 0), b2, voffB); PG8_STAGE(PG8_SB(0, 1), b2 + hstepB, voffB); PG8_STAGE(PG8_SA(0, 0), a2, voffA);
            PG8_WAIT_V(8); PG8_WAIT_L(0); PG8_BAR; PG8_MMA(1, 0, At, B0); PG8_MMA(1, 1, At, B1); PG8_BAR; PG8_SCHED;
            PG8_LDB(B0, 1, 0); PG8_LDB(B1, 1, 1); PG8_SCHED; PG8_LDA(At, 1, 0); PG8_STAGE(PG8_SA(0, 1), a2 + hstepA, voffA);
            PG8_WAIT_V(8); PG8_WAIT_L(0); PG8_BAR; PG8_MMA(0, 0, At, B0); PG8_MMA(0, 1, At, B1); PG8_BAR; PG8_SCHED;
            PG8_LDA(At, 1, 1); PG8_STAGE(PG8_SB(1, 0), b3, voffB); PG8_STAGE(PG8_SB(1, 1), b3 + hstepB, voffB); PG8_STAGE(PG8_SA(1, 0), a3, voffA);
            PG8_WAIT_V(8); PG8_WAIT_L(0); PG8_BAR; PG8_MMA(1, 0, At, B0); PG8_MMA(1, 1, At, B1); PG8_BAR; PG8_SCHED;
        }
        if (wr == 0) PG8_BAR;
        E(acc, cur, wr, wc, fr, fq);
        if (!has_next) break;
#pragma unroll
        for (int a = 0; a < 2; ++a)
#pragma unroll
            for (int b = 0; b < 2; ++b)
#pragma unroll
                for (int m = 0; m < 4; ++m)
#pragma unroll
                    for (int n = 0; n < 2; ++n) acc[a][b][m][n] = (f32x4){0.f, 0.f, 0.f, 0.f};
        cur = nxt; cAo = nAo; cB = nB; ++ui;
        if (wr == 1) PG8_BAR;
    }
    PG8_WAIT_V(0);
    PG8_BAR;
#undef PG8_AK
#undef PG8_SA
#undef PG8_SB
#undef PG8_STAGE
#undef PG8_LDA
#undef PG8_LDB
#undef PG8_MMA
#undef PG8_WAIT_V
#undef PG8_WAIT_L
#undef PG8_BAR
#undef PG8_SCHED
}
}

struct EpiP { bf16_t* o0; bf16_t* o1; bf16_t* o2; bf16_t* o3; float* f0; const float* v0; const float* v1; int ldc; float s; };
typedef f32x4 AccT[2][2][4][2];
template <int MODE> struct Epi {
    EpiP p;
    DEV void operator()(const AccT& acc, const pg8::Unit& u, int wr, int wc, int fr, int fq) const {
        const int row0 = u.pm * 256 + wr * 64 + fr;
        const int cl = wc * 32 + 8 * fq;
        if (MODE == 2) {
            u32x4 xv[2][4][2];
#pragma unroll
            for (int ai = 0; ai < 2; ++ai)
#pragma unroll
                for (int m = 0; m < 4; ++m)
#pragma unroll
                    for (int bj = 0; bj < 2; ++bj) xv[ai][m][bj] = *(const u32x4*)(p.o0 + (size_t)(row0 + ai * 128 + m * 16) * 1024 + u.pn * 256 + bj * 128 + cl);
#pragma unroll
            for (int ai = 0; ai < 2; ++ai)
#pragma unroll
                for (int m = 0; m < 4; ++m)
#pragma unroll
                    for (int bj = 0; bj < 2; ++bj) { float x[8]; unpack8(xv[ai][m][bj], x);
#pragma unroll
                        for (int n = 0; n < 2; ++n)
#pragma unroll
                            for (int i = 0; i < 4; ++i) x[n * 4 + i] = 1.41421356237f * x[n * 4 + i] + p.s * acc[ai][bj][m][n][i];
                        *(u32x4*)(p.o0 + (size_t)(row0 + ai * 128 + m * 16) * 1024 + u.pn * 256 + bj * 128 + cl) = pack8(x); }
            return;
        }
#pragma unroll
        for (int ai = 0; ai < 2; ++ai)
#pragma unroll
            for (int m = 0; m < 4; ++m) {
                const size_t row = (size_t)(row0 + ai * 128 + m * 16);
                if (MODE == 1) {
                    float h[8];
#pragma unroll
                    for (int n = 0; n < 2; ++n)
#pragma unroll
                        for (int i = 0; i < 4; ++i) { const float gt = acc[ai][0][m][n][i], up = acc[ai][1][m][n][i]; h[n * 4 + i] = gt * sigmoidf_(gt) * up; }
                    *(u32x4*)(p.o0 + row * 2816 + u.pn * 128 + cl) = pack8(h);
                } else {
#pragma unroll
                    for (int bj = 0; bj < 2; ++bj) {
                        float v[8];
#pragma unroll
                        for (int n = 0; n < 2; ++n)
#pragma unroll
                            for (int i = 0; i < 4; ++i) v[n * 4 + i] = acc[ai][bj][m][n][i];
                        const int col = u.pn * 256 + bj * 128 + cl;
                        if (MODE == 0) {
                            *(u32x4*)(p.o0 + row * p.ldc + col) = pack8(v);
                        } else if (MODE == 2) {
                            bf16_t* xp = p.o0 + row * 1024 + col; float x[8]; unpack8(*(const u32x4*)xp, x);
#pragma unroll
                            for (int i = 0; i < 8; ++i) x[i] = 1.41421356237f * x[i] + p.s * v[i];
                            *(u32x4*)xp = pack8(x);
                        } else if (MODE == 3) {
                            if (u.pn < 12) { bf16_t* base = p.o0 + (size_t)(u.pn >> 2) * E_EL;
                                *(u32x4*)(base + row * 1024 + (col & 1023)) = pack8(v);
                            } else { const int c = bj * 128 + cl;
                                if (bj == 1) {
#pragma unroll
                                    for (int i = 0; i < 8; ++i) v[i] = sigmoidf_(v[i]);
                                } else if (wc < 2) {
#pragma unroll
                                    for (int i = 0; i < 8; ++i) v[i] = tanhf_(v[i]);
                                }
                                *(u32x4*)(p.o3 + row * 256 + c) = pack8(v); }
                        } else if (MODE == 4) {
                            const int c = col & 1023;
                            if (u.pn < 4) {
#pragma unroll
                                for (int i = 0; i < 8; ++i) v[i] = 0.60653066f * sigmoidf_(p.v0[c + i] + v[i]);
                                *(u32x4*)(p.o0 + row * 1024 + c) = pack8(v);
                            } else if (u.pn < 8) {
#pragma unroll
                                for (int i = 0; i < 8; ++i) v[i] = sigmoidf_(p.v1[c + i] + v[i]);
                                *(u32x4*)(p.o1 + row * 1024 + c) = pack8(v);
                            } else *(u32x4*)(p.o2 + row * 1024 + c) = pack8(v);
                        } else if (MODE == 5) {
                            const int which = col >> 10, c = col & 1023, l = which & 1;
                            float* fo = p.f0 + (which < 2 ? O_MK : O_MV) + (size_t)l * 2097152 + row * 1024 + c;
                            *(f32x4*)fo = (f32x4){v[0], v[1], v[2], v[3]}; *(f32x4*)(fo + 4) = (f32x4){v[4], v[5], v[6], v[7]};
                            const int b = (int)(row >> 8), mem = (int)(row & 255);
                            if (which < 2) { *(u32x4*)(p.o0 + ((size_t)(l * 24 + b) * 256 + mem) * 1024 + c) = pack8(v); }
                            else { const int hh = c >> 8, d = c & 255; bf16_t* vt = p.o1 + ((size_t)((l * 24 + b) * 4 + hh) * 256 + d) * 256 + mem;
#pragma unroll
                                for (int i = 0; i < 8; ++i) vt[(size_t)i * 256] = f2bf(v[i]); }
                        }
                    }
                }
            }
    }
};

struct GD { pg8::Gemm g; EpiP ep; int mode; int coff; };
DEV void run_gemm(const GD& d, unsigned char* smem) {
    pg8::StaticOrder S; const int G = gridDim.x; S.init(d.g.M, d.g.N, G, (int)((blockIdx.x + d.coff) % G));
    LAS unsigned char* lds = (LAS unsigned char*)smem;
    switch (d.mode) {
        case 0: { Epi<0> e{d.ep}; pg8::gemm_phase(lds, d.g, S, e); } break;
        case 1: { Epi<1> e{d.ep}; pg8::gemm_phase(lds, d.g, S, e); } break;
        case 2: { Epi<2> e{d.ep}; pg8::gemm_phase(lds, d.g, S, e); } break;
        case 3: { Epi<3> e{d.ep}; pg8::gemm_phase(lds, d.g, S, e); } break;
        case 4: { Epi<4> e{d.ep}; pg8::gemm_phase(lds, d.g, S, e); } break;
        default: { Epi<5> e{d.ep}; pg8::gemm_phase(lds, d.g, S, e); } break;
    }
}

DEV void tconv_tile(const float* src, int ld, int col0, int k0, bf16_t* dst, int ldd, int n0, int kd0, const float* mu, int smode, float* tile) {
    const int tid = ltid();
#pragma unroll
    for (int i = 0; i < 2; ++i) {
        const int kk = (tid >> 4) + 32 * i, c4 = (tid & 15) * 4;
        const f32x4 v = *(const f32x4*)(src + (size_t)(k0 + kk) * ld + col0 + c4);
        float sc = 1.f; if (smode) { const float m = mu[k0 + kk]; sc = (smode == 1) ? (1.f - m) : m; }
        tile[kk * 65 + c4 + 0] = v[0] * sc; tile[kk * 65 + c4 + 1] = v[1] * sc; tile[kk * 65 + c4 + 2] = v[2] * sc; tile[kk * 65 + c4 + 3] = v[3] * sc;
    }
    __syncthreads();
    const int nn = tid >> 3, kc = (tid & 7) * 8;
    u32x4 o; o.x = pk2(tile[(kc + 0) * 65 + nn], tile[(kc + 1) * 65 + nn]); o.y = pk2(tile[(kc + 2) * 65 + nn], tile[(kc + 3) * 65 + nn]);
    o.z = pk2(tile[(kc + 4) * 65 + nn], tile[(kc + 5) * 65 + nn]); o.w = pk2(tile[(kc + 6) * 65 + nn], tile[(kc + 7) * 65 + nn]);
    *(u32x4*)(dst + (size_t)(n0 + nn) * ldd + kd0 + kc) = o;
    __syncthreads();
}
DEV void tconv_mat(const float* src, int ld, int K, int N, bf16_t* dst, int ldd, int kd0, int cmap, const float* mu, int smode, float* tile, int& base, int vb, int G) {
    const int nkb = K / 64, nt = nkb * (N / 64);
    const int start = (int)((vb + G - (base % G)) % G);
    for (int t = start; t < nt; t += G) {
        const int nb = t / nkb, kb = t % nkb; int col0 = nb * 64;
        if (cmap == 1) { const int pn = nb >> 2, bj = (nb >> 1) & 1, jb = nb & 1; col0 = bj * 2816 + pn * 128 + jb * 64; }
        tconv_tile(src, ld, col0, kb * 64, dst, ldd, nb * 64, kd0 + kb * 64, mu, smode, tile);
    }
    base += nt;
}
DEV void cvt_flat(const float* src, bf16_t* dst, size_t n8, int vb, int G) {
    for (size_t i = (size_t)vb * NTHR + ltid(); i < n8; i += (size_t)G * NTHR) {
        const f32x4 a = *(const f32x4*)(src + i * 8), b = *(const f32x4*)(src + i * 8 + 4);
        u32x4 o; o.x = pk2(a[0], a[1]); o.y = pk2(a[2], a[3]); o.z = pk2(b[0], b[1]); o.w = pk2(b[2], b[3]);
        *(u32x4*)(dst + i * 8) = o;
    }
}
DEV void prep_phase(const KP& P, unsigned char* smem, int part, int vb, int G) {
    float* tile = (float*)smem; bf16_t* W = (bf16_t*)P.ws; int base = 0;
    bf16_t* VT = (bf16_t*)(P.ws + WS_VT); bf16_t* KB = (bf16_t*)(P.ws + WS_KB);
#define TC(...) tconv_mat(__VA_ARGS__, tile, base, vb, G)
    for (int i = 2 * part; i < 2 * part + 2; ++i) TC(PIN(12) + (size_t)i * 1024 * 5632, 5632, 1024, 5632, W + W_UP + (size_t)i * 5632 * 1024, 1024, 0, 1, nullptr, 0);
    for (int i = 2 * part; i < 2 * part + 2; ++i) TC(PIN(13) + (size_t)i * 2816 * 1024, 1024, 2816, 1024, W + W_DN + (size_t)i * 1024 * 2816, 2816, 0, 0, nullptr, 0);
    { const int l = part;
        TC(PIN(14) + (size_t)l * 1048576, 1024, 1024, 1024, W + W_XQ + (size_t)l * 1048576, 1024, 0, 0, nullptr, 0);
        TC(PIN(17) + (size_t)l * 1048576, 1024, 1024, 1024, W + W_XO + (size_t)l * 1048576, 1024, 0, 0, nullptr, 0); }
    if (part == 0) {
        for (int l = 0; l < 2; ++l) {
            TC(PIN(15) + (size_t)l * 1048576, 1024, 1024, 1024, W + W_KV + (size_t)l * 1048576, 1024, 0, 0, nullptr, 0);
            TC(PIN(16) + (size_t)l * 1048576, 1024, 1024, 1024, W + W_KV + (size_t)(2 + l) * 1048576, 1024, 0, 0, nullptr, 0); }
        TC(PIN(18), 3072, 1024, 3072, W + W_IN, 1024, 0, 0, nullptr, 0);
        TC(PIN(28), 1024, 1024, 1024, W + W_O0, 1024, 0, 0, nullptr, 0);
    } else {
        for (int p = 0; p < 3; ++p) {
            TC(PIN(30) + (size_t)p * 1048576, 1024, 1024, 1024, W + W_P1 + (size_t)p * 1024 * 2048, 2048, 0, 0, PIN(29) + p * 1024, 1);
            TC(PIN(30) + (size_t)p * 1048576, 1024, 1024, 1024, W + W_P1 + (size_t)p * 1024 * 2048, 2048, 1024, 0, PIN(29) + p * 1024, 2); }
        TC(PIN(32), 64, 1024, 64, W + W_P1 + (size_t)3072 * 2048, 2048, 0, 0, PIN(29) + 3 * 1024, 1);
        TC(PIN(32), 64, 1024, 64, W + W_P1 + (size_t)3072 * 2048, 2048, 1024, 0, PIN(29) + 3 * 1024, 2);
        TC(PIN(35), 64, 1024, 64, W + W_P1 + (size_t)3136 * 2048, 2048, 0, 0, PIN(29) + 4 * 1024, 1);
        TC(PIN(35), 64, 1024, 64, W + W_P1 + (size_t)3136 * 2048, 2048, 1024, 0, PIN(29) + 4 * 1024, 2);
        TC(PIN(37), 128, 1024, 128, W + W_P1 + (size_t)3200 * 2048, 2048, 0, 0, PIN(29) + 5 * 1024, 1);
        TC(PIN(37), 128, 1024, 128, W + W_P1 + (size_t)3200 * 2048, 2048, 1024, 0, PIN(29) + 5 * 1024, 2);
        TC(PIN(44), 1024, 1024, 1024, W + W_O1, 1024, 0, 0, nullptr, 0);
    }
    for (int j = 64 * part; j < 64 * part + 64; ++j) { const int l = j >> 6, b = (j >> 2) & 15, h = j & 3;
        TC(PIN(9) + (size_t)((l * 16 + b) * 256) * 1024 + h * 256, 1024, 256, 256, VT + (size_t)((l * 24 + 8 + b) * 4 + h) * 65536, 256, 0, 0, nullptr, 0); }
#undef TC
    { const int l = part; cvt_flat(PIN(8) + (size_t)l * 16 * 256 * 1024, KB + (size_t)(l * 24 + 8) * 256 * 1024, (size_t)16 * 256 * 1024 / 8, vb, G); }
    if (part == 0) {
        bf16_t* XB = (bf16_t*)(P.ws + WS_XB);
        cvt_flat(PIN(0), XB, (size_t)MPROMPT * 1024 / 8, vb, G);
        cvt_flat(PIN(1), XB + (size_t)MPROMPT * 1024, (size_t)512 * 1024 / 8, vb, G);
        cvt_flat(PIN(2), (bf16_t*)(P.ws + WS_A4), (size_t)2048 * 1024 / 8, vb, G);
    } else {
        for (int i = vb * NTHR + ltid(); i < 3072 * 32; i += G * NTHR) {
            const int n = i >> 5, kc = (i & 31) * 8; float v[8];
#pragma unroll
            for (int j = 0; j < 8; ++j) { const int k = kc + j; float x = 0.f;
                if (n < 1024) { if (k < 64) x = PIN(33)[(size_t)k * 1024 + n]; }
                else if (n < 2048) { if (k >= 64 && k < 128) x = PIN(36)[(size_t)(k - 64) * 1024 + (n - 1024)]; }
                else { if (k >= 128) x = PIN(38)[(size_t)(k - 128) * 1024 + (n - 2048)]; }
                v[j] = x; }
            *(u32x4*)(W + W_L2 + (size_t)n * 256 + kc) = pack8(v);
        }
    }
}

DEV void ln_phase(bf16_t* X, const float* g, const float* b, bf16_t* Xp, float* outf, const float* shift_in, float* outbase, bool dry) {
    const int lane = ltid() & 63, wave = ltid() >> 6;
    float gg[16], bb[16];
#pragma unroll
    for (int j = 0; j < 8; ++j) { gg[j] = g[lane * 8 + j]; gg[8 + j] = g[512 + lane * 8 + j]; bb[j] = b[lane * 8 + j]; bb[8 + j] = b[512 + lane * 8 + j]; }
    u32x4 na = (u32x4){0u, 0u, 0u, 0u}, nb = na;
    { const int r0 = blockIdx.x * 8 + wave; if (r0 < MTOK) { na = *(const u32x4*)(X + (size_t)r0 * 1024 + lane * 8); nb = *(const u32x4*)(X + (size_t)r0 * 1024 + 512 + lane * 8); } }
    for (int row = blockIdx.x * 8 + wave; row < MTOK; row += gridDim.x * 8) {
        bf16_t* xr = X + (size_t)row * 1024;
        float v[16]; unpack8(na, v); unpack8(nb, v + 8);
        { const int nr = row + gridDim.x * 8; if (nr < MTOK) { na = *(const u32x4*)(X + (size_t)nr * 1024 + lane * 8); nb = *(const u32x4*)(X + (size_t)nr * 1024 + 512 + lane * 8); } }
        float s = 0.f;
#pragma unroll
        for (int j = 0; j < 16; ++j) s += v[j];
        const float mean = wave_sum(s) * (1.f / 1024.f); float s2 = 0.f;
#pragma unroll
        for (int j = 0; j < 16; ++j) { v[j] -= mean; s2 += v[j] * v[j]; }
        const float rstd = rsqrtf(wave_sum(s2) * (1.f / 1024.f) + 1e-5f);
#pragma unroll
        for (int j = 0; j < 16; ++j) v[j] = v[j] * rstd * gg[j] + bb[j];
        const u32x4 o0 = pack8(v), o1 = pack8(v + 8);
        if (!dry) { *(u32x4*)(xr + lane * 8) = o0; *(u32x4*)(xr + 512 + lane * 8) = o1; }
        if (outf) { float* fo = outf + (size_t)row * 1024;
#pragma unroll
            for (int j = 0; j < 16; ++j) v[j] *= DBG_YSCALE;
            *(f32x4*)(fo + lane * 8) = (f32x4){v[0], v[1], v[2], v[3]}; *(f32x4*)(fo + lane * 8 + 4) = (f32x4){v[4], v[5], v[6], v[7]};
            *(f32x4*)(fo + 512 + lane * 8) = (f32x4){v[8], v[9], v[10], v[11]}; *(f32x4*)(fo + 512 + lane * 8 + 4) = (f32x4){v[12], v[13], v[14], v[15]}; }
        if (Xp) {
            int t, T, bidx; const bool prompt = row < MPROMPT;
            if (prompt) { bidx = row >> 12; t = row & 4095; T = 4096; } else { const int r2 = row - MPROMPT; bidx = r2 >> 5; t = r2 & 31; T = 32; }
            if (t + 1 < T) { bf16_t* xn = Xp + (size_t)(row + 1) * 1024; *(u32x4*)(xn + lane * 8) = o0; *(u32x4*)(xn + 512 + lane * 8) = o1; }
            else { float* so = outbase + (prompt ? O_PSHIFT : O_SSHIFT) + (size_t)bidx * 1024;
#pragma unroll
                for (int j = 0; j < 16; ++j) v[j] *= DBG_SHSCALE;
                *(f32x4*)(so + lane * 8) = (f32x4){v[0], v[1], v[2], v[3]}; *(f32x4*)(so + lane * 8 + 4) = (f32x4){v[4], v[5], v[6], v[7]};
                *(f32x4*)(so + 512 + lane * 8) = (f32x4){v[8], v[9], v[10], v[11]}; *(f32x4*)(so + 512 + lane * 8 + 4) = (f32x4){v[12], v[13], v[14], v[15]}; }
            if (t == 0) { bf16_t* x0 = Xp + (size_t)row * 1024; float z[16];
#pragma unroll
                for (int j = 0; j < 8; ++j) { z[j] = prompt ? 0.f : shift_in[(size_t)bidx * 1024 + lane * 8 + j]; z[8 + j] = prompt ? 0.f : shift_in[(size_t)bidx * 1024 + 512 + lane * 8 + j]; }
                *(u32x4*)(x0 + lane * 8) = pack8(z); *(u32x4*)(x0 + 512 + lane * 8) = pack8(z + 8); }
        }
    }
}

DEV void attn_phase(const bf16_t* Q, const bf16_t* KBl, const bf16_t* VTl, bf16_t* AO, unsigned char* smem) {
    const int tid = ltid(), lane = tid & 63, wave = tid >> 6, fr = lane & 15, g = lane >> 4;
    bf16_t* Ks = (bf16_t*)smem;
    bf16_t* Vs = (bf16_t*)(smem + 64 * 264 * 2);
    for (int job = blockIdx.x; job < 1088; job += gridDim.x) {
        int s, h, row0, nvalid;
        if (job < 1024) { s = job >> 7; h = (job >> 5) & 3; row0 = s * 4096 + (job & 31) * 128; nvalid = 128; }
        else { const int j2 = job - 1024; s = 8 + (j2 >> 2); h = j2 & 3; row0 = MPROMPT + (s - 8) * 32; nvalid = 32; }
        const int myrow = wave * 16 + fr; const bool valid = myrow < nvalid;
        const bf16_t* qp = Q + (size_t)(row0 + (valid ? myrow : 0)) * 1024 + h * 256 + g * 8;
        bf16x8 qf[8];
#pragma unroll
        for (int s8 = 0; s8 < 8; ++s8) qf[s8] = *(const bf16x8*)(qp + s8 * 32);
        f32x4 sc[16];
#pragma unroll
        for (int i = 0; i < 16; ++i) sc[i] = (f32x4){0.f, 0.f, 0.f, 0.f};
        const bf16_t* Kg = KBl + (size_t)s * 256 * 1024 + h * 256;
        const bf16_t* Vg = VTl + (size_t)(s * 4 + h) * 65536;
        u32x4 pre[4];
#pragma unroll
        for (int i = 0; i < 4; ++i) { const int ch = tid + i * 512, key = ch >> 5, dc = (ch & 31) * 8; pre[i] = *(const u32x4*)(Kg + (size_t)key * 1024 + dc); }
#pragma unroll
        for (int kt4 = 0; kt4 < 4; ++kt4) {
            __syncthreads();
#pragma unroll
            for (int i = 0; i < 4; ++i) { const int ch = tid + i * 512, key = ch >> 5, dc = (ch & 31) * 8; *(u32x4*)(Ks + key * 264 + dc) = pre[i]; }
            __syncthreads();
            if (kt4 < 3) {
#pragma unroll
                for (int i = 0; i < 4; ++i) { const int ch = tid + i * 512, key = ch >> 5, dc = (ch & 31) * 8; pre[i] = *(const u32x4*)(Kg + (size_t)((kt4 + 1) * 64 + key) * 1024 + dc); }
            } else {
#pragma unroll
                for (int i = 0; i < 4; ++i) { const int ch = tid + i * 512, d = ch >> 3, kc = (ch & 7) * 8; pre[i] = *(const u32x4*)(Vg + (size_t)d * 256 + kc); }
            }
#pragma unroll
            for (int kt = 0; kt < 4; ++kt)
#pragma unroll
                for (int s8 = 0; s8 < 8; ++s8) { const bf16x8 kf = *(const bf16x8*)(Ks + (kt * 16 + fr) * 264 + s8 * 32 + g * 8);
                    sc[kt4 * 4 + kt] = mfma16(kf, qf[s8], sc[kt4 * 4 + kt]); }
        }
        float mx = -3.0e38f;
#pragma unroll
        for (int i = 0; i < 16; ++i)
#pragma unroll
            for (int r = 0; r < 4; ++r) mx = fmaxf(mx, sc[i][r]);
        mx = fmaxf(mx, __shfl_xor(mx, 16)); mx = fmaxf(mx, __shfl_xor(mx, 32));
        float sum = 0.f;
#pragma unroll
        for (int i = 0; i < 16; ++i)
#pragma unroll
            for (int r = 0; r < 4; ++r) { const float pv = exp2f((sc[i][r] - mx) * (0.0625f * 1.44269504f)); sc[i][r] = pv; sum += pv; }
        sum += __shfl_xor(sum, 16); sum += __shfl_xor(sum, 32);
        bf16x8 pf[8];
#pragma unroll
        for (int s2 = 0; s2 < 8; ++s2) { u32x4 o; o.x = pk2(sc[2 * s2][0], sc[2 * s2][1]); o.y = pk2(sc[2 * s2][2], sc[2 * s2][3]);
            o.z = pk2(sc[2 * s2 + 1][0], sc[2 * s2 + 1][1]); o.w = pk2(sc[2 * s2 + 1][2], sc[2 * s2 + 1][3]); pf[s2] = __builtin_bit_cast(bf16x8, o); }
        f32x4 oa[16];
#pragma unroll
        for (int i = 0; i < 16; ++i) oa[i] = (f32x4){0.f, 0.f, 0.f, 0.f};
#pragma unroll
        for (int vt4 = 0; vt4 < 4; ++vt4) {
            __syncthreads();
#pragma unroll
            for (int i = 0; i < 4; ++i) { const int ch = tid + i * 512, d = ch >> 3, kc = (ch & 7) * 8; *(u32x4*)(Vs + d * 72 + kc) = pre[i]; }
            __syncthreads();
            if (vt4 < 3) {
#pragma unroll
                for (int i = 0; i < 4; ++i) { const int ch = tid + i * 512, d = ch >> 3, kc = (ch & 7) * 8; pre[i] = *(const u32x4*)(Vg + (size_t)d * 256 + (vt4 + 1) * 64 + kc); }
            }
#pragma unroll
            for (int s2l = 0; s2l < 2; ++s2l)
#pragma unroll
                for (int dt = 0; dt < 16; ++dt) {
                    const bf16_t* vp = Vs + (dt * 16 + fr) * 72 + 32 * s2l + 4 * g;
                    const u32x2 lo = *(const u32x2*)vp, hi = *(const u32x2*)(vp + 16);
                    u32x4 c; c.x = lo.x; c.y = lo.y; c.z = hi.x; c.w = hi.y;
                    oa[dt] = mfma16(__builtin_bit_cast(bf16x8, c), pf[vt4 * 2 + s2l], oa[dt]);
                }
        }
        const float inv = 1.f / sum;
        if (valid) { bf16_t* op = AO + (size_t)(row0 + myrow) * 1024 + h * 256 + 4 * g;
#pragma unroll
            for (int dt = 0; dt < 16; ++dt) { u32x2 o; o.x = pk2(oa[dt][0] * inv, oa[dt][1] * inv); o.y = pk2(oa[dt][2] * inv, oa[dt][3] * inv); *(u32x2*)(op + dt * 16) = o; } }
    }
}

DEV void ret_job(int s, int h, const KP& P, const bf16_t* PB, bf16_t* YM, unsigned char* smem) {
    const int tid = ltid(), lane = tid & 63, w = tid >> 6, fr = lane & 15, g = lane >> 4;
    const bool prompt = s < 8; const int T = prompt ? 4096 : 32, C = prompt ? DBG_C_RET : 32, nch = T / C;
    const int row0 = prompt ? s * 4096 : MPROMPT + (s - 8) * 32, pos0 = prompt ? 0 : 4096;
    const float log2g = log2f(1.f - exp2f(-5.f - (float)h));
    const float cdecay = exp2f(log2g * (float)C);
    bf16_t* Qs = (bf16_t*)smem;
    bf16_t* Ks = (bf16_t*)(smem + 17408);
    bf16_t* Kt = (bf16_t*)(smem + 34816);
    bf16_t* Vt = (bf16_t*)(smem + 53248);
    bf16_t* St = (bf16_t*)(smem + 71680);
    bf16_t* Ps = (bf16_t*)(smem + 106496);
    float* Os = (float*)smem;
    const float* st_in = prompt ? nullptr : PIN(5) + (size_t)((s - 8) * 4 + h) * 16384;
    float* st_out = P.out + (prompt ? O_PRET + (size_t)(s * 4 + h) * 16384 : O_SRET + (size_t)((s - 8) * 4 + h) * 16384);
    f32x4 Sacc[8];
#pragma unroll
    for (int dvt = 0; dvt < 8; ++dvt)
#pragma unroll
        for (int r = 0; r < 4; ++r) Sacc[dvt][r] = st_in ? st_in[(size_t)(16 * w + 4 * g + r) * 128 + dvt * 16 + fr] : 0.f;
    __syncthreads();
    for (int i = tid; i < 71680 / 16; i += NTHR) ((u32x4*)smem)[i] = (u32x4){0u, 0u, 0u, 0u};
#pragma unroll
    for (int dvt = 0; dvt < 8; ++dvt) { u32x2 o; o.x = pk2(Sacc[dvt][0], Sacc[dvt][1]); o.y = pk2(Sacc[dvt][2], Sacc[dvt][3]);
        *(u32x2*)(St + (dvt * 16 + fr) * 136 + 16 * w + 4 * g) = o; }
    __syncthreads();
    const float* gng = PIN(26) + h * 128; const float* gnb = PIN(27) + h * 128;
    u32x4 pq1 = (u32x4){0u, 0u, 0u, 0u}, pq2 = pq1, pk1 = pq1, pk2r = pq1, pv0 = pq1, pv1 = pq1, pg0 = pq1, pg1 = pq1;
#define RET_LOAD(ch_) do { const bf16_t* bp_ = PB + (size_t)(row0 + (ch_) * C + (tid >> 3)) * 3072 + h * 128; const int sg_ = tid & 7; \
        pq1 = *(const u32x4*)(bp_ + 1024 + sg_ * 8); pq2 = *(const u32x4*)(bp_ + 1024 + 64 + sg_ * 8); pk1 = *(const u32x4*)(bp_ + 1536 + sg_ * 8); pk2r = *(const u32x4*)(bp_ + 1536 + 64 + sg_ * 8); \
        pv0 = *(const u32x4*)(bp_ + 2048 + sg_ * 16); pv1 = *(const u32x4*)(bp_ + 2048 + sg_ * 16 + 8); } while (0)
    if ((tid >> 3) < C) RET_LOAD(0);
    for (int ch = 0; ch < nch; ++ch) {
        {
            const int t = tid >> 3, seg = tid & 7;
            if (t < C) {
                float q1[8], q2[8], k1[8], k2[8];
                unpack8(pq1, q1); unpack8(pq2, q2); unpack8(pk1, k1); unpack8(pk2r, k2);
                const u32x4 v0 = pv0, v1 = pv1;
                const float pos = (float)(pos0 + ch * C + t);
                const float zeta = exp2f(log2g * (float)(C - 1 - t));
                float qa[8], qb[8], ka[8], kb[8];
#pragma unroll
                for (int j = 0; j < 8; ++j) {
                    const int d = seg * 8 + j;
                    const float invf = exp2f(-(float)d * (13.287712379549449f / 64.f));
                    const float rev = pos * invf * 0.15915494309189535f; const float frc = rev - floorf(rev);
                    const float sn = __builtin_amdgcn_sinf(frc), cs = __builtin_amdgcn_cosf(frc);
                    qa[j] = q1[j] * cs - q2[j] * sn; qb[j] = q1[j] * sn + q2[j] * cs;
                    ka[j] = (k1[j] * cs - k2[j] * sn) * 0.08838834764831845f; kb[j] = (k1[j] * sn + k2[j] * cs) * 0.08838834764831845f;
                    Kt[d * 72 + t] = f2bf(ka[j] * zeta); Kt[(64 + d) * 72 + t] = f2bf(kb[j] * zeta);
                }
                *(u32x4*)(Qs + t * 136 + seg * 8) = pack8(qa); *(u32x4*)(Qs + t * 136 + 64 + seg * 8) = pack8(qb);
                *(u32x4*)(Ks + t * 136 + seg * 8) = pack8(ka); *(u32x4*)(Ks + t * 136 + 64 + seg * 8) = pack8(kb);
                const unsigned vv[8] = {v0.x, v0.y, v0.z, v0.w, v1.x, v1.y, v1.z, v1.w};
#pragma unroll
                for (int j = 0; j < 8; ++j) { Vt[(seg * 16 + 2 * j) * 72 + t] = (bf16_t)(vv[j] & 0xffffu); Vt[(seg * 16 + 2 * j + 1) * 72 + t] = (bf16_t)(vv[j] >> 16); }
                { const bf16_t* gp_ = PB + (size_t)(row0 + ch * C + t) * 3072 + 2560 + h * 128 + seg * 16; pg0 = *(const u32x4*)gp_; pg1 = *(const u32x4*)(gp_ + 8); }
                if (ch + 1 < nch) RET_LOAD(ch + 1);
            }
        }
        __syncthreads();
        {
            const int jt = w & 3;
#pragma unroll
            for (int x = 0; x < 2; ++x) {
                const int it = 2 * (w >> 2) + x; f32x4 a = (f32x4){0.f, 0.f, 0.f, 0.f};
#pragma unroll
                for (int s4 = 0; s4 < 4; ++s4) a = mfma16(*(const bf16x8*)(Ks + (jt * 16 + fr) * 136 + s4 * 32 + g * 8), *(const bf16x8*)(Qs + (it * 16 + fr) * 136 + s4 * 32 + g * 8), a);
                const int i = it * 16 + fr; float pr[4];
#pragma unroll
                for (int r = 0; r < 4; ++r) { const int j = jt * 16 + 4 * g + r; pr[r] = (i >= j) ? a[r] * exp2f(log2g * (float)(i - j)) : 0.f; }
                u32x2 o; o.x = pk2(pr[0], pr[1]); o.y = pk2(pr[2], pr[3]);
                *(u32x2*)(Ps + i * 72 + jt * 16 + 4 * g) = o;
            }
        }
        __syncthreads();
        f32x4 oacc[4];
        {
            const int it = w & 3;
#pragma unroll
            for (int x = 0; x < 4; ++x) {
                const int dvt = 4 * (w >> 2) + x; f32x4 a = (f32x4){0.f, 0.f, 0.f, 0.f};
#pragma unroll
                for (int s4 = 0; s4 < 4; ++s4) a = mfma16(*(const bf16x8*)(Qs + (it * 16 + fr) * 136 + s4 * 32 + g * 8), *(const bf16x8*)(St + (dvt * 16 + fr) * 136 + s4 * 32 + g * 8), a);
#pragma unroll
                for (int r = 0; r < 4; ++r) a[r] *= exp2f(log2g * (float)(it * 16 + 4 * g + r + 1));
#pragma unroll
                for (int s2 = 0; s2 < 2; ++s2) a = mfma16(*(const bf16x8*)(Ps + (it * 16 + fr) * 72 + s2 * 32 + g * 8), *(const bf16x8*)(Vt + (dvt * 16 + fr) * 72 + s2 * 32 + g * 8), a);
                oacc[x] = a;
            }
#pragma unroll
            for (int dvt = 0; dvt < 8; ++dvt) {
                f32x4 a = Sacc[dvt] * cdecay;
#pragma unroll
                for (int s2 = 0; s2 < 2; ++s2) a = mfma16(*(const bf16x8*)(Kt + (16 * w + fr) * 72 + s2 * 32 + g * 8), *(const bf16x8*)(Vt + (dvt * 16 + fr) * 72 + s2 * 32 + g * 8), a);
                Sacc[dvt] = a;
            }
        }
        __syncthreads();
        {
            const int it = w & 3;
#pragma unroll
            for (int x = 0; x < 4; ++x) { const int dvt = 4 * (w >> 2) + x;
#pragma unroll
                for (int r = 0; r < 4; ++r) Os[(it * 16 + 4 * g + r) * 132 + dvt * 16 + fr] = oacc[x][r]; }
#pragma unroll
            for (int dvt = 0; dvt < 8; ++dvt) { u32x2 o; o.x = pk2(Sacc[dvt][0], Sacc[dvt][1]); o.y = pk2(Sacc[dvt][2], Sacc[dvt][3]);
                *(u32x2*)(St + (dvt * 16 + fr) * 136 + 16 * w + 4 * g) = o; }
        }
        __syncthreads();
        {
            const int i = tid >> 3, seg = tid & 7; float o[16]; float sm = 0.f;
#pragma unroll
            for (int j = 0; j < 16; ++j) { o[j] = Os[i * 132 + seg * 16 + j]; sm += o[j]; }
            const float mean = red8(sm) * (1.f / 128.f); float s2 = 0.f;
#pragma unroll
            for (int j = 0; j < 16; ++j) { o[j] -= mean; s2 += o[j] * o[j]; }
            const float rstd = rsqrtf(red8(s2) * (1.f / 128.f) + 1e-5f);
            if (i < C) {
                const size_t row = (size_t)(row0 + ch * C + i);
                float gt[16]; unpack8(pg0, gt); unpack8(pg1, gt + 8);
#pragma unroll
                for (int j = 0; j < 16; ++j) { const float y = o[j] * rstd * gng[seg * 16 + j] + gnb[seg * 16 + j]; o[j] = y * gt[j] * sigmoidf_(gt[j]); }
                *(u32x4*)(YM + row * 1024 + 512 + h * 128 + seg * 16) = pack8(o); *(u32x4*)(YM + row * 1024 + 512 + h * 128 + seg * 16 + 8) = pack8(o + 8);
            }
        }
        __syncthreads();
    }
#pragma unroll
    for (int dvt = 0; dvt < 8; ++dvt)
#pragma unroll
        for (int r = 0; r < 4; ++r) st_out[(size_t)(16 * w + 4 * g + r) * 128 + dvt * 16 + fr] = Sacc[dvt][r] * DBG_RETSCALE;
}

DEV void lru_job(int s, int gb, const KP& P, const bf16_t* PB, bf16_t* YM, unsigned char* smem) {
    const int tid = ltid(), lane = tid & 63, w = tid >> 6, fr = lane & 15, g = lane >> 4;
    const bool prompt = s < 8; const int T = prompt ? 4096 : 32, C = prompt ? DBG_C : 32, nch = T / C;
    const int row0 = prompt ? s * 4096 : MPROMPT + (s - 8) * 32, bidx = prompt ? s : s - 8;
    bf16_t* Wt = (bf16_t*)smem;
    bf16_t* Xc = (bf16_t*)(smem + 18432);
    float* Xr = (float*)(smem + 27648);
    float* GA = (float*)(smem + 44800);
    float* GI = (float*)(smem + 61440);
    __syncthreads();
    for (int i = tid; i < 128 * 64; i += NTHR) { const int co = i >> 6, ci = i & 63;
        const float* wsrc = (co < 64) ? PIN(21) : PIN(23);
        Wt[co * 72 + ci] = f2bf(wsrc[(size_t)gb * 4096 + ci * 64 + (co & 63)]); }
    for (int i = tid; i < 64 * 72 / 2; i += NTHR) ((unsigned*)Xc)[i] = 0u;
    if (tid < 192) { const int j = tid >> 6, c = tid & 63; Xr[j * 64 + c] = prompt ? 0.f : PIN(3)[(size_t)(bidx * 3 + j) * 512 + gb * 64 + c]; }
    const int t = tid >> 3, seg = tid & 7, c0 = gb * 64 + seg * 8;
    float cw[4][8], cb[8], spl[8];
#pragma unroll
    for (int j = 0; j < 8; ++j) { cb[j] = PIN(20)[c0 + j]; const float lam = PIN(25)[c0 + j]; spl[j] = -8.f * log1pf(__expf(-lam));
#pragma unroll
        for (int q = 0; q < 4; ++q) cw[q][j] = PIN(19)[q * 512 + c0 + j]; }
    float* SUMS = (float*)(smem + 78080);
    float* HC = (float*)(smem + 82176);
    if (tid < 64) HC[tid] = prompt ? 0.f : PIN(4)[(size_t)bidx * 512 + gb * 64 + tid];
    const float* bias_g = (w < 4) ? PIN(22) : PIN(24);
    __syncthreads();
    u32x4 px = (u32x4){0u, 0u, 0u, 0u}, pga = px;
    if (t < C) px = *(const u32x4*)(PB + (size_t)(row0 + t) * 3072 + c0);
    for (int ch = 0; ch < nch; ++ch) {
        if (t < C) { float x[8]; unpack8(px, x);
#pragma unroll
            for (int j = 0; j < 8; ++j) Xr[(3 + t) * 64 + seg * 8 + j] = x[j];
            pga = *(const u32x4*)(PB + (size_t)(row0 + ch * C + t) * 3072 + 512 + c0);
            if (ch + 1 < nch) px = *(const u32x4*)(PB + (size_t)(row0 + (ch + 1) * C + t) * 3072 + c0); }
        __syncthreads();
        float xc[8];
#pragma unroll
        for (int j = 0; j < 8; ++j) xc[j] = 0.f;
        if (t < C) {
#pragma unroll
            for (int j = 0; j < 8; ++j) { float a = cb[j];
#pragma unroll
                for (int q = 0; q < 4; ++q) a += cw[q][j] * Xr[(t + q) * 64 + seg * 8 + j];
                xc[j] = a; }
            *(u32x4*)(Xc + t * 72 + seg * 8) = pack8(xc);
        }
        __syncthreads();
        {
            const int tt = w & 3;
#pragma unroll
            for (int x = 0; x < 4; ++x) { const int cot = 4 * (w >> 2) + x; f32x4 a = (f32x4){0.f, 0.f, 0.f, 0.f};
#pragma unroll
                for (int s2 = 0; s2 < 2; ++s2) a = mfma16(*(const bf16x8*)(Xc + (tt * 16 + fr) * 72 + s2 * 32 + g * 8), *(const bf16x8*)(Wt + (cot * 16 + fr) * 72 + s2 * 32 + g * 8), a);
                const int co = (cot & 3) * 16 + fr; const float bs = bias_g[gb * 64 + co]; float* dst = (w < 4) ? GA : GI;
#pragma unroll
                for (int r = 0; r < 4; ++r) dst[(tt * 16 + 4 * g + r) * 65 + co] = sigmoidf_(a[r] + bs); }
        }
        __syncthreads();
        if (t < C) {
#pragma unroll
            for (int j = 0; j < 8; ++j) { const int c = seg * 8 + j; const float rg = GA[t * 65 + c], ig = GI[t * 65 + c];
                const float la = spl[j] * rg, a = __expf(la); const float mult = sqrtf(fmaxf(1.f - a * a, 0.f));
                GA[t * 65 + c] = a; GI[t * 65 + c] = mult * (ig * xc[j]); }
        }
        __syncthreads();
        {
            const int SEG = C >> 3, wu = __builtin_amdgcn_readfirstlane(w);
            float pl[8], hl[8]; float pp = 1.f, hh = 0.f;
#pragma unroll
            for (int j = 0; j < 8; ++j) if (j < SEG) { const int tt = wu * SEG + j; const float a_ = GA[tt * 65 + lane], u_ = GI[tt * 65 + lane]; hh = a_ * hh + u_; pp *= a_; hl[j] = hh; pl[j] = pp; }
            SUMS[(wu * 64 + lane) * 2] = pp; SUMS[(wu * 64 + lane) * 2 + 1] = hh;
            if (wu == 1) { const float r0 = Xr[(C + 0) * 64 + lane], r1 = Xr[(C + 1) * 64 + lane], r2 = Xr[(C + 2) * 64 + lane];
                Xr[lane] = r0; Xr[64 + lane] = r1; Xr[128 + lane] = r2; }
            __syncthreads();
            float carry = HC[lane];
            for (int w2 = 0; w2 < wu; ++w2) carry = SUMS[(w2 * 64 + lane) * 2] * carry + SUMS[(w2 * 64 + lane) * 2 + 1];
#pragma unroll
            for (int j = 0; j < 8; ++j) if (j < SEG) GI[(wu * SEG + j) * 65 + lane] = hl[j] + pl[j] * carry;
            const float ncar = pp * carry + hh;
            __syncthreads();
            if (wu == 7) HC[lane] = ncar;
        }
        if (t < C) { const size_t row = (size_t)(row0 + ch * C + t); float ga[8]; unpack8(pga, ga); float y[8];
#pragma unroll
            for (int j = 0; j < 8; ++j) { const float x = ga[j]; const float ge = 0.5f * x * (1.f + tanhf_(0.7978845608f * (x + 0.044715f * x * x * x))); y[j] = GI[t * 65 + seg * 8 + j] * ge; }
            *(u32x4*)(YM + row * 1024 + c0) = pack8(y); }
        __syncthreads();
    }
    if (tid < 64) P.out[(prompt ? O_PLRU : O_SLRU) + (size_t)bidx * 512 + gb * 64 + tid] = HC[tid] * DBG_LRUSCALE;
    if (tid < 192) { const int j = tid >> 6, c = tid & 63; P.out[(prompt ? O_PCONV : O_SCONV) + (size_t)(bidx * 3 + j) * 512 + gb * 64 + c] = Xr[j * 64 + c] * DBG_CONVSCALE; }
    __syncthreads();
}

DEV void wkv_job(int s, int h, const KP& P, bf16_t* RO, const bf16_t* Kk, const bf16_t* Vv, const bf16_t* Ee, const bf16_t* Aa, const bf16_t* Gg, unsigned char* smem, bool dry) {
    const int tid = ltid(), q = tid & 15, rp = tid >> 4;
    const bool prompt = s < 8; const int T = prompt ? 4096 : 32, nch = T / 32;
    const int row0 = prompt ? s * 4096 : MPROMPT + (s - 8) * 32, bidx = prompt ? s : s - 8;
    float* vec = (float*)smem;
    float* vvb = (float*)(smem + 81920);
    float* rkb = (float*)(smem + 98304);
    float* ob = (float*)(smem + 98560);
    const float* sin_ = prompt ? nullptr : PIN(7) + (size_t)(bidx * 16 + h) * 4096;
    float* sout = P.out + (prompt ? O_PWKV : O_SWKV) + (size_t)(bidx * 16 + h) * 4096;
    const int cc = h * 64 + 4 * q;
    f32x4 S0 = (f32x4){0.f, 0.f, 0.f, 0.f}, S1 = S0;
    if (sin_) { S0 = *(const f32x4*)(sin_ + rp * 64 + 4 * q); S1 = *(const f32x4*)(sin_ + (rp + 32) * 64 + 4 * q); }
    const f32x4 kkw = *(const f32x4*)(PIN(39) + cc), kaw = *(const f32x4*)(PIN(40) + cc), rkw = *(const f32x4*)(PIN(41) + cc);
    const f32x4 gng = *(const f32x4*)(PIN(42) + cc), gnb = *(const f32x4*)(PIN(43) + cc);
    u32x2 rr, rk_, rv, re, ra, rg;
#define WKV_LOAD(c_) do { const size_t o_ = (size_t)(row0 + (c_) * 32 + rp) * 1024 + cc; rr = *(const u32x2*)(RO + o_); rk_ = *(const u32x2*)(Kk + o_); \
        rv = *(const u32x2*)(Vv + o_); re = *(const u32x2*)(Ee + o_); ra = *(const u32x2*)(Aa + o_); } while (0)
#define WKV_DERIVE(buf_) do { \
        const f32x4 rf = (f32x4){bflo(rr.x), bfhi(rr.x), bflo(rr.y), bfhi(rr.y)}, kf = (f32x4){bflo(rk_.x), bfhi(rk_.x), bflo(rk_.y), bfhi(rk_.y)}; \
        const f32x4 vf = (f32x4){bflo(rv.x), bfhi(rv.x), bflo(rv.y), bfhi(rv.y)}, ef = (f32x4){bflo(re.x), bfhi(re.x), bflo(re.y), bfhi(re.y)}; \
        const f32x4 af = (f32x4){bflo(ra.x), bfhi(ra.x), bflo(ra.y), bfhi(ra.y)}; \
        f32x4 kkv = kf * kkw; const float ss = red16(kkv[0] * kkv[0] + kkv[1] * kkv[1] + kkv[2] * kkv[2] + kkv[3] * kkv[3]); \
        const float inv = 1.f / fmaxf(sqrtf(ss), 1e-12f); kkv = kkv * inv; \
        const f32x4 km = kf * (1.f + (af - 1.f) * kaw); \
        f32x4 wv; wv[0] = __expf(-ef[0]); wv[1] = __expf(-ef[1]); wv[2] = __expf(-ef[2]); wv[3] = __expf(-ef[3]); \
        const f32x4 t3 = rf * km * rkw; const float rks = red16(t3[0] + t3[1] + t3[2] + t3[3]); \
        float* vb_ = vec + ((buf_) * 32 + rp) * 320 + 4 * q; \
        *(f32x4*)(vb_) = -kkv; *(f32x4*)(vb_ + 64) = wv; *(f32x4*)(vb_ + 128) = kkv * af; *(f32x4*)(vb_ + 192) = km; *(f32x4*)(vb_ + 256) = rf; \
        *(f32x4*)(vvb + ((buf_) * 32 + rp) * 64 + 4 * q) = vf; if (q == 0) rkb[(buf_) * 32 + rp] = rks; } while (0)
    __syncthreads();
    WKV_LOAD(0); WKV_DERIVE(0);
    __syncthreads();
    for (int c = 0; c < nch; ++c) {
        const int buf = c & 1;
        if (c + 1 < nch) WKV_LOAD(c + 1);
        rg = *(const u32x2*)(Gg + (size_t)(row0 + c * 32 + rp) * 1024 + cc);
        const float* vb = vec + buf * 32 * 320 + 4 * q; const float* vvp = vvb + buf * 32 * 64;
        f32x4 n4 = *(const f32x4*)(vb), w4 = *(const f32x4*)(vb + 64), b4 = *(const f32x4*)(vb + 128), k4 = *(const f32x4*)(vb + 192), r4 = *(const f32x4*)(vb + 256);
        float v0 = vvp[rp], v1 = vvp[rp + 32];
#pragma unroll 4
        for (int t = 0; t < 32; ++t) {
            const int tn = (t + 1) & 31;
            const f32x4 n4n = *(const f32x4*)(vb + tn * 320), w4n = *(const f32x4*)(vb + tn * 320 + 64), b4n = *(const f32x4*)(vb + tn * 320 + 128),
                        k4n = *(const f32x4*)(vb + tn * 320 + 192), r4n = *(const f32x4*)(vb + tn * 320 + 256);
            const float v0n = vvp[tn * 64 + rp], v1n = vvp[tn * 64 + rp + 32];
            const float sa0 = red16(S0[0] * n4[0] + S0[1] * n4[1] + S0[2] * n4[2] + S0[3] * n4[3]);
            const float sa1 = red16(S1[0] * n4[0] + S1[1] * n4[1] + S1[2] * n4[2] + S1[3] * n4[3]);
            S0 = S0 * w4 + (b4 * sa0 + k4 * v0);
            S1 = S1 * w4 + (b4 * sa1 + k4 * v1);
            const float o0 = red16(S0[0] * r4[0] + S0[1] * r4[1] + S0[2] * r4[2] + S0[3] * r4[3]);
            const float o1 = red16(S1[0] * r4[0] + S1[1] * r4[1] + S1[2] * r4[2] + S1[3] * r4[3]);
            if (q == 0) { ob[t * 64 + rp] = o0; ob[t * 64 + rp + 32] = o1; }
            n4 = n4n; w4 = w4n; b4 = b4n; k4 = k4n; r4 = r4n; v0 = v0n; v1 = v1n;
        }
        __syncthreads();
        {
            f32x4 o = *(const f32x4*)(ob + rp * 64 + 4 * q);
            const float mean = red16(o[0] + o[1] + o[2] + o[3]) * (1.f / 64.f); o = o - mean;
            const float var = red16(o[0] * o[0] + o[1] * o[1] + o[2] * o[2] + o[3] * o[3]) * (1.f / 64.f);
            const float rstd = rsqrtf(var + 64e-5f);
            const f32x4 vf = *(const f32x4*)(vvp + rp * 64 + 4 * q); const float rks = rkb[buf * 32 + rp];
            const f32x4 gf = (f32x4){bflo(rg.x), bfhi(rg.x), bflo(rg.y), bfhi(rg.y)};
            const f32x4 y = (o * rstd * gng + gnb + vf * rks) * gf;
            u32x2 st; st.x = pk2(y[0], y[1]); st.y = pk2(y[2], y[3]);
            if (!dry) *(u32x2*)(RO + (size_t)(row0 + c * 32 + rp) * 1024 + cc) = st;
        }
        if (c + 1 < nch) WKV_DERIVE(buf ^ 1);
        __syncthreads();
    }
    *(f32x4*)(sout + rp * 64 + 4 * q) = S0 * DBG_WKVSCALE; *(f32x4*)(sout + (rp + 32) * 64 + 4 * q) = S1 * DBG_WKVSCALE;
#undef WKV_LOAD
#undef WKV_DERIVE
}


DEV void wkv_half(int s, int h, int half, const KP& P, bf16_t* RO, const bf16_t* Kk, const bf16_t* Vv, const bf16_t* Ee, const bf16_t* Aa, const bf16_t* Gg, unsigned long long* xch, unsigned char* smem) {
    const int tid = ltid(), q = tid & 15, rp = tid >> 4;
    const bool prompt = s < 8; const int T = prompt ? 4096 : 32, nch = T / 32;
    const int row0 = prompt ? s * 4096 : MPROMPT + (s - 8) * 32, bidx = prompt ? s : s - 8;
    float* vec = (float*)smem;
    float* vvb = (float*)(smem + 81920);
    float* rkb = (float*)(smem + 98304);
    float* ob = (float*)(smem + 98560);
    float* statb = (float*)(smem + 106752);
    const int crow = half * 32;
    const float* sin_ = prompt ? nullptr : PIN(7) + (size_t)(bidx * 16 + h) * 4096;
    float* sout = P.out + (prompt ? O_PWKV : O_SWKV) + (size_t)(bidx * 16 + h) * 4096;
    const size_t gbase = prompt ? (size_t)(s * 16 + h) * 4096 : (size_t)128 * 4096 + (size_t)((s - 8) * 16 + h) * 32;
    const int cc = h * 64 + 4 * q, c2 = h * 64 + crow + 2 * q;
    f32x4 S0 = (f32x4){0.f, 0.f, 0.f, 0.f};
    if (sin_) S0 = *(const f32x4*)(sin_ + (crow + rp) * 64 + 4 * q);
    const f32x4 kkw = *(const f32x4*)(PIN(39) + cc), kaw = *(const f32x4*)(PIN(40) + cc), rkw = *(const f32x4*)(PIN(41) + cc);
    const float gw0 = PIN(42)[c2], gw1 = PIN(42)[c2 + 1], gb0 = PIN(43)[c2], gb1 = PIN(43)[c2 + 1];
    u32x2 rr, rk_, rv, re, ra; unsigned rgp = 0u;
#define WKV_LOAD(c_) do { const size_t o_ = (size_t)(row0 + (c_) * 32 + rp) * 1024 + cc; rr = *(const u32x2*)(RO + o_); rk_ = *(const u32x2*)(Kk + o_); \
        rv = *(const u32x2*)(Vv + o_); re = *(const u32x2*)(Ee + o_); ra = *(const u32x2*)(Aa + o_); } while (0)
#define WKV_DERIVE(buf_) do { \
        const f32x4 rf = (f32x4){bflo(rr.x), bfhi(rr.x), bflo(rr.y), bfhi(rr.y)}, kf = (f32x4){bflo(rk_.x), bfhi(rk_.x), bflo(rk_.y), bfhi(rk_.y)}; \
        const f32x4 vf = (f32x4){bflo(rv.x), bfhi(rv.x), bflo(rv.y), bfhi(rv.y)}, ef = (f32x4){bflo(re.x), bfhi(re.x), bflo(re.y), bfhi(re.y)}; \
        const f32x4 af = (f32x4){bflo(ra.x), bfhi(ra.x), bflo(ra.y), bfhi(ra.y)}; \
        f32x4 kkv = kf * kkw; const float ss = red16(kkv[0] * kkv[0] + kkv[1] * kkv[1] + kkv[2] * kkv[2] + kkv[3] * kkv[3]); \
        const float inv = 1.f / fmaxf(sqrtf(ss), 1e-12f); kkv = kkv * inv; \
        const f32x4 km = kf * (1.f + (af - 1.f) * kaw); \
        f32x4 wv; wv[0] = __expf(-ef[0]); wv[1] = __expf(-ef[1]); wv[2] = __expf(-ef[2]); wv[3] = __expf(-ef[3]); \
        const f32x4 t3 = rf * km * rkw; const float rks = red16(t3[0] + t3[1] + t3[2] + t3[3]); \
        float* vb_ = vec + ((buf_) * 32 + rp) * 320 + 4 * q; \
        *(f32x4*)(vb_) = -kkv; *(f32x4*)(vb_ + 64) = wv; *(f32x4*)(vb_ + 128) = kkv * af; *(f32x4*)(vb_ + 192) = km; *(f32x4*)(vb_ + 256) = rf; \
        *(f32x4*)(vvb + ((buf_) * 32 + rp) * 64 + 4 * q) = vf; if (q == 0) rkb[(buf_) * 32 + rp] = rks; } while (0)
#define WKV_FINAL(cc_, fb_) do { \
        unsigned long long* pg_ = xch + ((gbase + (size_t)((cc_) * 32 + rp)) * 2 + (half ^ 1)); unsigned long long pv_; unsigned sp_ = 0u; \
        do { pv_ = __hip_atomic_load(pg_, __ATOMIC_RELAXED, __HIP_MEMORY_SCOPE_AGENT); if ((unsigned)pv_ != 0xFFFFFFFFu) break; __builtin_amdgcn_s_sleep(1); } while (++sp_ < (1u << 22)); \
        const float sm_ = statb[((fb_) * 32 + rp) * 2] + __uint_as_float((unsigned)pv_), sq_ = statb[((fb_) * 32 + rp) * 2 + 1] + __uint_as_float((unsigned)(pv_ >> 32)); \
        const float mean_ = sm_ * (1.f / 64.f), var_ = fmaxf(sq_ * (1.f / 64.f) - mean_ * mean_, 0.f), rstd_ = rsqrtf(var_ + 64e-5f); \
        const float o0_ = ob[((fb_) * 32 + rp) * 32 + 2 * q], o1_ = ob[((fb_) * 32 + rp) * 32 + 2 * q + 1]; \
        const float v0_ = vvb[((fb_) * 32 + rp) * 64 + crow + 2 * q], v1_ = vvb[((fb_) * 32 + rp) * 64 + crow + 2 * q + 1], rks_ = rkb[(fb_) * 32 + rp]; \
        const float y0_ = ((o0_ - mean_) * rstd_ * gw0 + gb0 + v0_ * rks_) * bflo(rgp), y1_ = ((o1_ - mean_) * rstd_ * gw1 + gb1 + v1_ * rks_) * bfhi(rgp); \
        *(unsigned*)(RO + (size_t)(row0 + (cc_) * 32 + rp) * 1024 + c2) = pk2(y0_, y1_); } while (0)
    __syncthreads();
    WKV_LOAD(0); WKV_DERIVE(0);
    __syncthreads();
    for (int c = 0; c < nch; ++c) {
        const int buf = c & 1;
        if (c + 1 < nch) WKV_LOAD(c + 1);
        if (c > 0) rgp = *(const unsigned*)(Gg + (size_t)(row0 + (c - 1) * 32 + rp) * 1024 + c2);
        const float* vb = vec + buf * 32 * 320 + 4 * q; const float* vvp = vvb + buf * 32 * 64 + crow;
        f32x4 n4 = *(const f32x4*)(vb), w4 = *(const f32x4*)(vb + 64), b4 = *(const f32x4*)(vb + 128), k4 = *(const f32x4*)(vb + 192), r4 = *(const f32x4*)(vb + 256);
        float v0 = vvp[rp];
#pragma unroll 4
        for (int t = 0; t < 32; ++t) {
            const int tn = (t + 1) & 31;
            const f32x4 n4n = *(const f32x4*)(vb + tn * 320), w4n = *(const f32x4*)(vb + tn * 320 + 64), b4n = *(const f32x4*)(vb + tn * 320 + 128),
                        k4n = *(const f32x4*)(vb + tn * 320 + 192), r4n = *(const f32x4*)(vb + tn * 320 + 256);
            const float v0n = vvp[tn * 64 + rp];
            const float sa0 = red16(S0[0] * n4[0] + S0[1] * n4[1] + S0[2] * n4[2] + S0[3] * n4[3]);
            S0 = S0 * w4 + (b4 * sa0 + k4 * v0);
            const float o0 = red16(S0[0] * r4[0] + S0[1] * r4[1] + S0[2] * r4[2] + S0[3] * r4[3]);
            if (q == 0) ob[(buf * 32 + t) * 32 + rp] = o0;
            n4 = n4n; w4 = w4n; b4 = b4n; k4 = k4n; r4 = r4n; v0 = v0n;
        }
        __syncthreads();
        {
            const float o0 = ob[(buf * 32 + rp) * 32 + 2 * q], o1 = ob[(buf * 32 + rp) * 32 + 2 * q + 1];
            const float sm = red16(o0 + o1), sq = red16(o0 * o0 + o1 * o1);
            if (q == 0) { statb[(buf * 32 + rp) * 2] = sm; statb[(buf * 32 + rp) * 2 + 1] = sq;
                __hip_atomic_store(xch + ((gbase + (size_t)(c * 32 + rp)) * 2 + half), (unsigned long long)__float_as_uint(sm) | ((unsigned long long)__float_as_uint(sq) << 32), __ATOMIC_RELAXED, __HIP_MEMORY_SCOPE_AGENT); }
        }
        if (c > 0) WKV_FINAL(c - 1, buf ^ 1);
        __syncthreads();
        if (c + 1 < nch) WKV_DERIVE(buf ^ 1);
        __syncthreads();
    }
    rgp = *(const unsigned*)(Gg + (size_t)(row0 + (nch - 1) * 32 + rp) * 1024 + c2);
    WKV_FINAL(nch - 1, (nch - 1) & 1);
    *(f32x4*)(sout + (crow + rp) * 64 + 4 * q) = S0;
#undef WKV_LOAD
#undef WKV_DERIVE
#undef WKV_FINAL
}

#define XB_TMO      128
#define XB_XCNT(j)  (256  + 64 * (j))
#define XB_XSUB(j)  (1280 + 64 * (j))
#define XB_XGEN(j)  (2304 + 64 * (j))
#define XB_TOP      3328
#define XB_TOPGEN   3392
#define XCD_BAR_WORDS 3456
#define XB_SPIN_CAP (1u << 22)
DEV unsigned xb_ld(unsigned* p)              { return __hip_atomic_load(p, __ATOMIC_RELAXED, __HIP_MEMORY_SCOPE_AGENT); }
DEV unsigned xb_add(unsigned* p, unsigned v) { return __hip_atomic_fetch_add(p, v, __ATOMIC_RELAXED, __HIP_MEMORY_SCOPE_AGENT); }
DEV unsigned xb_xcc_id() { return (unsigned)__builtin_amdgcn_s_getreg((3 << 11) | 20) & 0xFu; }
#define XB_SPIN(cond, bar) do { unsigned _sp = 0; while (cond) { __builtin_amdgcn_s_sleep(1); \
    if ((++_sp & 255u) == 0u) { if (xb_ld(&(bar)[XB_TMO])) break; if (_sp > XB_SPIN_CAP) { atomicAdd(&(bar)[XB_TMO], 1u); break; } } } } while (0)
struct XcdBarrier { unsigned* bar; unsigned x; volatile LAS unsigned* st; };
DEV XcdBarrier xcd_barrier_post(unsigned* bar, volatile LAS unsigned* st) {
    XcdBarrier b; b.bar = bar; b.x = xb_xcc_id(); b.st = st;
    if (threadIdx.x == 0) (void)xb_add(&bar[XB_XCNT(b.x)], 1u);
    return b;
}
DEV void xcd_barrier_complete(unsigned* bar, unsigned x, unsigned& nloc, unsigned& nx) {
    const unsigned G = gridDim.x * gridDim.y * gridDim.z;
    unsigned sum, cnt, mine, sp = 0u;
    for (;;) {
        sum = 0u; cnt = 0u; mine = 0u;
#pragma unroll
        for (unsigned j = 0; j < 16; ++j) { const unsigned c = xb_ld(&bar[XB_XCNT(j)]); sum += c; cnt += (c > 0u) ? 1u : 0u; mine = (j == x) ? c : mine; }
        if (sum == G) break;
        __builtin_amdgcn_s_sleep(1);
        if ((++sp & 255u) == 0u) { if (xb_ld(&bar[XB_TMO])) break; if (sp > XB_SPIN_CAP) { atomicAdd(&bar[XB_TMO], 1u); break; } }
    }
    nloc = mine > 0u ? mine : 1u; nx = cnt > 0u ? cnt : 1u;
}
DEV void xcd_barrier(const XcdBarrier& b) {
    asm volatile("s_waitcnt vmcnt(0)" ::: "memory");
    __syncthreads();
    if (threadIdx.x == 0) {
        unsigned* bar = b.bar;
        __builtin_amdgcn_s_waitcnt(0);
        unsigned nloc = b.st[0], nx = b.st[1];
        if (nloc == 0u) { xcd_barrier_complete(bar, b.x, nloc, nx); b.st[0] = nloc; b.st[1] = nx; }
        const unsigned old = xb_add(&bar[XB_XSUB(b.x)], 1u);
        const unsigned gen = old / nloc;
        if (old + 1u == (gen + 1u) * nloc) {
            __builtin_amdgcn_fence(__ATOMIC_RELEASE, "agent");
            asm volatile("s_waitcnt vmcnt(0)" ::: "memory");
            const unsigned og = xb_add(&bar[XB_TOP], 1u);
            const unsigned tg = og / nx;
            if (og + 1u == (tg + 1u) * nx) xb_add(&bar[XB_TOPGEN], 1u);
            else XB_SPIN(xb_ld(&bar[XB_TOPGEN]) == tg, bar);
            __builtin_amdgcn_fence(__ATOMIC_ACQUIRE, "agent");
            xb_add(&bar[XB_XGEN(b.x)], 1u);
            asm volatile("s_waitcnt vmcnt(0)" ::: "memory");
        } else {
            XB_SPIN(xb_ld(&bar[XB_XGEN(b.x)]) == gen, bar);
            __builtin_amdgcn_fence(__ATOMIC_ACQUIRE, "agent");
            asm volatile("s_waitcnt vmcnt(0)" ::: "memory");
        }
    }
    __syncthreads();
}

__global__ void __launch_bounds__(NTHR, 2) mega(KP P) {
    extern __shared__ __attribute__((aligned(16))) unsigned char smem[];
    cg::grid_group grid = cg::this_grid();
    unsigned char* ws = P.ws;
    bf16_t* W = (bf16_t*)ws;
    bf16_t* KB = (bf16_t*)(ws + WS_KB); bf16_t* VT = (bf16_t*)(ws + WS_VT);
    bf16_t* XB = (bf16_t*)(ws + WS_XB); bf16_t* A1 = (bf16_t*)(ws + WS_A1); bf16_t* A2 = (bf16_t*)(ws + WS_A2);
    bf16_t* A3 = (bf16_t*)(ws + WS_A3); bf16_t* A4 = (bf16_t*)(ws + WS_A4); bf16_t* HL = (bf16_t*)(ws + WS_HL);
    bf16_t* D1 = (bf16_t*)P.out; bf16_t* D2 = D1 + E_EL;
    {
        if (threadIdx.x == 0) { *(volatile LAS unsigned*)((LAS unsigned char*)smem + LDS_BYTES - 16) = 0u; *(volatile LAS unsigned*)((LAS unsigned char*)smem + LDS_BYTES - 12) = 0u; }
        __syncthreads();
    }
    const XcdBarrier xbar = xcd_barrier_post((unsigned*)(ws + WS_END), (volatile LAS unsigned*)((LAS unsigned char*)smem + LDS_BYTES - 16));
    for (int ph = P.ph_lo; ph < P.ph_hi; ++ph) {
        GD d; d.mode = -1; d.coff = 0; d.ep = EpiP{nullptr, nullptr, nullptr, nullptr, nullptr, nullptr, nullptr, 0, 0.f};
        int lnidx = -1; int attl = -1;
#define GEMM_SET(A0_, A1_, Bt_, lda_, K_, nt0_, M_, N_, mode_) do { d.g = pg8::Gemm{A0_, A1_, Bt_, lda_, K_, nt0_, M_, N_}; d.mode = mode_; } while (0)
        switch (ph) {
            case 0: prep_phase(P, smem, 0, (int)blockIdx.x, (int)gridDim.x); break;
            case 1: { GD d2; d2.coff = 128; d2.mode = 5; d2.g = pg8::Gemm{A4, A4, W + W_KV, 1024, 1024, 16, 2048, 4096};
                      d2.ep = EpiP{KB, VT, nullptr, nullptr, P.out, nullptr, nullptr, 0, 0.f}; run_gemm(d2, smem); }
            case 12: case 15: case 27: { const int wi = (ph == 1) ? 0 : (ph == 12 ? 1 : (ph == 15 ? 2 : 3));
                      GEMM_SET(XB, XB, W + W_UP + (size_t)wi * 5632 * 1024, 1024, 1024, 16, MTOK, 5632, 1); d.ep.o0 = A1; } break;
            case 2: case 13: case 16: case 28: { const int wi = (ph == 2) ? 0 : (ph == 13 ? 1 : (ph == 16 ? 2 : 3));
                      GEMM_SET(A1, A1, W + W_DN + (size_t)wi * 1024 * 2816, 2816, 2816, 44, MTOK, 1024, 2); d.ep.o0 = XB; d.ep.s = 0.5f; } break;
            case 3: lnidx = 0; break; case 7: lnidx = 1; break; case 11: lnidx = 2; break; case 14: lnidx = 3; break;
            case 17: lnidx = 4; break; case 22: lnidx = 5; break; case 26: lnidx = 6; break; case 29: lnidx = 7; break;
            case 4: GEMM_SET(XB, XB, W + W_IN, 1024, 1024, 16, MTOK, 3072, 0); d.ep.o0 = A1; d.ep.ldc = 3072; break;
            case 5: for (int rep = 0; rep < DBG_MIXREP; ++rep) for (int job = blockIdx.x; job < 288; job += gridDim.x) {
                        if (job < 32) ret_job(job >> 2, job & 3, P, A1, A4, smem);
                        else if (job < 96) lru_job((job - 32) >> 3, (job - 32) & 7, P, A1, A4, smem);
                        else if (job < 160) ret_job(8 + ((job - 96) >> 2), (job - 96) & 3, P, A1, A4, smem);
                        else lru_job(8 + ((job - 160) >> 3), (job - 160) & 7, P, A1, A4, smem);
                    }
                    if (gridDim.x > 128) { if (blockIdx.x >= 96) { __syncthreads(); prep_phase(P, smem, 1, (int)blockIdx.x - 96, (int)gridDim.x - 96); } }
                    else { __syncthreads(); prep_phase(P, smem, 1, (int)blockIdx.x, (int)gridDim.x); }
                    break;
            case 6: GEMM_SET(A4, A4, W + W_O0, 1024, 1024, 16, MTOK, 1024, 2); d.ep.o0 = XB; d.ep.s = 1.f; break;
            case 8: GEMM_SET(XB, XB, W + W_XQ, 1024, 1024, 16, MTOK, 1024, 0); d.ep.o0 = A1; d.ep.ldc = 1024; break;
            case 9: for (int rep = 0; rep < DBG_ATTREP; ++rep) attn_phase(A1, KB, VT, A2, smem); break;
            case 10: GEMM_SET(A2, A2, W + W_XO, 1024, 1024, 16, MTOK, 1024, 2); d.ep.o0 = XB; d.ep.s = 1.f; break;
            case 18: GEMM_SET(XB, A4, W + W_P1, 1024, 2048, 16, MTOK, 3328, 3); d.ep.o0 = A1; d.ep.o1 = A2; d.ep.o2 = A3; d.ep.o3 = HL; break;
            case 19: GEMM_SET(HL, HL, W + W_L2, 256, 256, 4, MTOK, 3072, 4); d.ep.o0 = D1; d.ep.o1 = D2; d.ep.o2 = A4; d.ep.v0 = PIN(31); d.ep.v1 = PIN(34); break;
            case 20: if (gridDim.x == 256) {
                        unsigned long long* xch = (unsigned long long*)(ws + WS_END + 16384);
                        const int hf = blockIdx.x & 1, pj = blockIdx.x >> 1;
                        wkv_half(pj >> 4, pj & 15, hf, P, A1, A2, A3, D1, D2, A4, xch, smem);
                        wkv_half(8 + (pj >> 4), pj & 15, hf, P, A1, A2, A3, D1, D2, A4, xch, smem);
                        wkv_half(8 + ((pj + 128) >> 4), (pj + 128) & 15, hf, P, A1, A2, A3, D1, D2, A4, xch, smem);
                    } else for (int job = blockIdx.x; job < 384; job += gridDim.x) {
                        if (job < 128) wkv_job(job >> 4, job & 15, P, A1, A2, A3, D1, D2, A4, smem, false);
                        else wkv_job(8 + ((job - 128) >> 4), (job - 128) & 15, P, A1, A2, A3, D1, D2, A4, smem, false);
                    } break;
            case 21: GEMM_SET(A1, A1, W + W_O1, 1024, 1024, 16, MTOK, 1024, 2); d.ep.o0 = XB; d.ep.s = 1.f; break;
            case 23: GEMM_SET(XB, XB, W + W_XQ + 1048576, 1024, 1024, 16, MTOK, 1024, 0); d.ep.o0 = A2; d.ep.ldc = 1024; break;
            case 24: attn_phase(A2, KB + (size_t)24 * 256 * 1024, VT + (size_t)24 * 256 * 1024, A3, smem); break;
            case 25: GEMM_SET(A3, A3, W + W_XO + 1048576, 1024, 1024, 16, MTOK, 1024, 2); d.ep.o0 = XB; d.ep.s = 1.f; break;
            default: break;
        }
        if (d.mode >= 0) run_gemm(d, smem);
        if (DBG_GREP > 1 && ph == 4) run_gemm(d, smem);
        if (DBG_LNREP > 1 && lnidx == 0) ln_phase(XB, PIN(10) + lnidx * 1024, PIN(11) + lnidx * 1024, nullptr, nullptr, PIN(6), P.out, P.ph_hi < 1000);
        if (lnidx >= 0) ln_phase(XB, PIN(10) + lnidx * 1024, PIN(11) + lnidx * 1024, lnidx == 4 ? A4 : nullptr, lnidx == 7 ? P.out + O_Y : nullptr, PIN(6), P.out, false);
        (void)attl;
        if (ph == 6) for (int rep = 0; rep < DBG_SYNCREP; ++rep) { __threadfence(); grid.sync(); __builtin_amdgcn_fence(__ATOMIC_ACQUIRE, "agent"); asm volatile("buffer_inv sc1" ::: "memory"); }
        if (ph + 1 < P.ph_hi) {
            if (P.ph_lo == 0x7fffffff) grid.sync();
            xcd_barrier(xbar);
        }
    }
}

extern "C" void kernel_launch(void* const* d_in, const int* in_sizes, int n_in, void* d_out, int out_size, void* d_ws, size_t ws_size, hipStream_t stream) {
    static int grid_blocks = 0;
    if (grid_blocks == 0) {
        if (n_in != 45 || ws_size < WS_END + 16384 + 8519680) { fprintf(stderr, "kernel_launch: unexpected n_in %d or ws_size %zu (< %zu)\n", n_in, ws_size, (size_t)WS_END); grid_blocks = -1; return; }
        int dev = 0, cus = 0, per_cu = 0;
        hipGetDevice(&dev);
        hipDeviceGetAttribute(&cus, hipDeviceAttributeMultiprocessorCount, dev);
        if (hipFuncSetAttribute((const void*)mega, hipFuncAttributeMaxDynamicSharedMemorySize, LDS_BYTES) != hipSuccess) { fprintf(stderr, "kernel_launch: hipFuncSetAttribute failed\n"); grid_blocks = -1; return; }
        hipOccupancyMaxActiveBlocksPerMultiprocessor(&per_cu, (const void*)mega, NTHR, LDS_BYTES);
        if (per_cu < 1) { fprintf(stderr, "kernel_launch: occupancy query returned %d\n", per_cu); per_cu = 1; }
        (void)hipGetLastError();
        grid_blocks = cus * per_cu;
    }
    if (grid_blocks < 0) return;
    if (hipMemsetAsync((char*)d_ws + WS_END, 0, 16384, stream) != hipSuccess) { fprintf(stderr, "kernel_launch: memset of the barrier word failed\n"); return; }
    if (hipMemsetAsync((char*)d_ws + WS_END + 16384, 0xFF, 8519680, stream) != hipSuccess) { fprintf(stderr, "kernel_launch: memset of the exchange granules failed\n"); return; }
    KP p{};
    for (int i = 0; i < 45; ++i) p.in[i] = (const float*)d_in[i];
    p.out = (float*)d_out; p.ws = (unsigned char*)d_ws; p.ph_lo = 0; p.ph_hi = 30;
    void* args[] = {&p};
    hipError_t e = hipLaunchCooperativeKernel((const void*)mega, dim3(grid_blocks), dim3(NTHR), args, LDS_BYTES, stream);
    if (e != hipSuccess) fprintf(stderr, "cooperative launch failed: %s (grid %d)\n", hipGetErrorString(e), grid_blocks);
}
```

```cpp
#include <hip/hip_runtime.h>
#include <hip/hip_cooperative_groups.h>
#include <cstdio>
#include <cstdint>
namespace cg = cooperative_groups;

#define LAS __attribute__((address_space(3)))
#define DEV __device__ __forceinline__
typedef unsigned short bf16_t;
typedef short bf16x8 __attribute__((ext_vector_type(8)));
typedef float f32x4 __attribute__((ext_vector_type(4)));
typedef unsigned u32x4 __attribute__((ext_vector_type(4)));
typedef unsigned u32x2 __attribute__((ext_vector_type(2)));

constexpr int MTOK = 33280, DM = 1024, MPROMPT = 32768, NTHR = 512;
constexpr int LDS_BYTES = 147456;
#define DBG_C 64
#define DBG_C_RET 64
#define DBG_SCANREP 1
#define DBG_MIXREP 1
#define DBG_GREP 1
#define DBG_SYNCREP 0
#define DBG_LNREP 1
#define DBG_ATTREP 1
#define DBG_PREPREP 1
#define DBG_YSCALE 1.0f
#define DBG_SHSCALE 1.0f
#define DBG_WKVSCALE 1.0f
#define DBG_RETSCALE 1.0f
#define DBG_LRUSCALE 1.0f
#define DBG_CONVSCALE 1.0f
constexpr size_t E_EL = (size_t)MTOK * DM;
constexpr size_t W_UP = 0;
constexpr size_t W_DN = W_UP + (size_t)4 * 5632 * 1024;
constexpr size_t W_XQ = W_DN + (size_t)4 * 1024 * 2816;
constexpr size_t W_XO = W_XQ + (size_t)2 * 1048576;
constexpr size_t W_KV = W_XO + (size_t)2 * 1048576;
constexpr size_t W_IN = W_KV + (size_t)4096 * 1024;
constexpr size_t W_O0 = W_IN + (size_t)3072 * 1024;
constexpr size_t W_P1 = W_O0 + (size_t)1048576;
constexpr size_t W_L2 = W_P1 + (size_t)3328 * 2048;
constexpr size_t W_O1 = W_L2 + (size_t)3072 * 256;
constexpr size_t W_END = W_O1 + (size_t)1048576;
constexpr size_t KV_EL = (size_t)2 * 24 * 256 * 1024;
constexpr size_t WS_KB = W_END * 2;
constexpr size_t WS_VT = WS_KB + KV_EL * 2;
constexpr size_t WS_XB = WS_VT + KV_EL * 2;
constexpr size_t WS_A1 = WS_XB + E_EL * 2;
constexpr size_t WS_A2 = WS_A1 + E_EL * 2;
constexpr size_t WS_A3 = WS_A2 + E_EL * 2;
constexpr size_t WS_A4 = WS_A3 + E_EL * 2;
constexpr size_t WS_HL = WS_A4 + E_EL * 2;
constexpr size_t WS_END = WS_HL + (size_t)MTOK * 256 * 2;
constexpr size_t O_Y = 0, O_MK = 34078720, O_MV = 38273024, O_PCONV = 42467328, O_PLRU = 42479616, O_PRET = 42483712,
                 O_PSHIFT = 43008000, O_PWKV = 43016192, O_SCONV = 43540480, O_SLRU = 43565056, O_SRET = 43573248,
                 O_SSHIFT = 44621824, O_SWKV = 44638208;

struct KP { const float* in[45]; float* out; unsigned char* ws; int ph_lo, ph_hi; };

DEV int ltid() { int t = threadIdx.x; asm volatile("" : "+v"(t)); return t; }
DEV const float* pin(const KP& P, int k) { asm volatile("" : "+s"(k)); return P.in[k]; }
#define PIN(k) pin(P, k)
typedef float f32x2_t __attribute__((ext_vector_type(2)));
typedef __bf16 bf16x2_t __attribute__((ext_vector_type(2)));
DEV unsigned pk2(float lo, float hi) { const f32x2_t v = {lo, hi}; return __builtin_bit_cast(unsigned, __builtin_convertvector(v, bf16x2_t)); }
DEV float bflo(unsigned u) { return __uint_as_float(u << 16); }
DEV float bfhi(unsigned u) { return __uint_as_float(u & 0xffff0000u); }
DEV float bf1(bf16_t b) { return __uint_as_float(((unsigned)b) << 16); }
DEV bf16_t f2bf(float f) { return (bf16_t)(pk2(f, f) & 0xffffu); }
DEV float sigmoidf_(float x) { return __builtin_amdgcn_rcpf(1.f + __expf(-x)); }
DEV float tanhf_(float x) { return 1.f - 2.f / (__expf(2.f * x) + 1.f); }
template <int CTRL> DEV float dppf(float v) { return __builtin_bit_cast(float, __builtin_amdgcn_update_dpp(0, __builtin_bit_cast(int, v), CTRL, 0xf, 0xf, true)); }
DEV float red8(float v) { v += dppf<0xB1>(v); v += dppf<0x4E>(v); v += dppf<0x141>(v); return v; }
DEV float red16(float v) { v = red8(v); v += dppf<0x140>(v); return v; }
DEV float wave_sum(float v) {
#pragma unroll
    for (int o = 1; o < 64; o <<= 1) v += __shfl_xor(v, o);
    return v;
}
DEV void unpack8(u32x4 u, float* f) { f[0] = bflo(u.x); f[1] = bfhi(u.x); f[2] = bflo(u.y); f[3] = bfhi(u.y); f[4] = bflo(u.z); f[5] = bfhi(u.z); f[6] = bflo(u.w); f[7] = bfhi(u.w); }
DEV u32x4 pack8(const float* f) { u32x4 o; o.x = pk2(f[0], f[1]); o.y = pk2(f[2], f[3]); o.z = pk2(f[4], f[5]); o.w = pk2(f[6], f[7]); return o; }
DEV f32x4 mfma16(bf16x8 a, bf16x8 b, f32x4 c) { return __builtin_amdgcn_mfma_f32_16x16x32_bf16(a, b, c, 0, 0, 0); }

namespace pg8 {
constexpr int BM = 256, BK = 64, HALF = 128, HTB = HALF * BK * 2, NXCD = 8, WGM = 8;
DEV int lds_byte(int r, int c) { const int st = (r >> 4) * 2 + (c >> 5), rr = r & 15, cc = c & 31, ob = rr * 64 + cc * 2; return st * 1024 + (ob ^ (((ob >> 9) & 1) << 5)); }
DEV void stage_rc(int b, int& R, int& C) { const int st = b / 1024, sb = b % 1024, swz = sb ^ (((sb >> 9) & 1) << 5); R = (st >> 1) * 16 + swz / 64; C = (st & 1) * 32 + (swz % 64) / 2; }
DEV int perm32(int rho) { const int n = rho >> 4, i = rho & 15; return 8 * (i >> 2) + 4 * n + (i & 3); }
struct Unit { int pm, pn; };
struct Gemm { const bf16_t* A0; const bf16_t* A1; const bf16_t* Bt; int lda, K, nt0, M, N; };
struct StaticOrder {
    int nM, nN, nwg, G, c;
    DEV void init(int M, int N, int G_, int c_) { nM = M / BM; nN = N / BM; nwg = nM * nN; G = G_; c = c_; }
    DEV bool next(int i, Unit& u) const {
        const long L = (long)i * G + c; if (L >= nwg) return false;
        int wgid = (int)L; { const int q = nwg / NXCD, r = nwg % NXCD, xcd = wgid % NXCD, off = wgid / NXCD; wgid = (xcd < r ? xcd * (q + 1) : r * (q + 1) + (xcd - r) * q) + off; }
        const int nig = WGM * nN, gid = wgid / nig, fm = gid * WGM, gsz = (nM - fm) < WGM ? (nM - fm) : WGM;
        u.pm = fm + ((wgid % nig) % gsz); u.pn = (wgid % nig) / gsz; return true;
    }
};

template <class Epi>
DEV void gemm_phase(LAS unsigned char* lds, const Gemm g, const StaticOrder& S, const Epi& E) {
    const int tid = ltid(), wid = __builtin_amdgcn_readfirstlane(tid >> 6), lane = tid & 63, wr = wid >> 2, wc = wid & 3, fr = lane & 15, fq = lane >> 4;
    const int K = g.K, nt = K / BK, lda = g.lda, nt0 = g.nt0;
    unsigned voffA[2], voffB[2];
#pragma unroll
    for (int i = 0; i < 2; ++i) { int R, C; stage_rc(tid * 16 + i * 8192, R, C); const int Rb = (R & ~31) + perm32(R & 31);
        voffA[i] = (unsigned)(R * lda + C) * 2u; voffB[i] = (unsigned)(Rb * K + C) * 2u; }
    const size_t kstep = (size_t)(BK * 2);
    const size_t hstepA = (size_t)HALF * lda * 2, hstepB = (size_t)HALF * K * 2;
    const size_t tstepA = 2 * hstepA, tstepB = 2 * hstepB;
    const unsigned ldsw = (unsigned)wid * 1024u;
    const int aoff = lds_byte(wr * 64 + fr, fq * 8), boff = lds_byte(wc * 32 + fr, fq * 8);
    const char* const gA0 = (const char*)g.A0; const char* const gA1 = (const char*)g.A1 - (size_t)nt0 * kstep;
#define PG8_AK(rowoff, kt) (((kt) < nt0 ? gA0 : gA1) + (rowoff) + (size_t)(kt) * kstep)
#define PG8_SA(b, h) (((b) * 2 + (h)) * HTB)
#define PG8_SB(b, h) ((4 + (b) * 2 + (h)) * HTB)
#define PG8_STAGE(bufoff, gbase, voff) do { _Pragma("unroll") for (int _i = 0; _i < 2; ++_i) \
        __builtin_amdgcn_global_load_lds((const unsigned*)((const char*)(gbase) + (voff)[_i]), (LAS unsigned*)(lds + (bufoff) + ldsw + _i * 8192), 16, 0, 0); } while (0)
#define PG8_LDA(dst, b, h) do { _Pragma("unroll") for (int m = 0; m < 4; ++m) _Pragma("unroll") for (int k = 0; k < 2; ++k) dst[m][k] = *(const LAS bf16x8*)(lds + PG8_SA(b, h) + aoff + m * 2048 + k * 1024); } while (0)
#define PG8_LDB(dst, b, h) do { _Pragma("unroll") for (int n = 0; n < 2; ++n) _Pragma("unroll") for (int k = 0; k < 2; ++k) dst[n][k] = *(const LAS bf16x8*)(lds + PG8_SB(b, h) + boff + n * 2048 + k * 1024); } while (0)
#define PG8_MMA(ai, bj, At, Bt) do { __builtin_amdgcn_s_setprio(1); _Pragma("unroll") for (int m = 0; m < 4; ++m) _Pragma("unroll") for (int n = 0; n < 2; ++n) _Pragma("unroll") for (int k = 0; k < 2; ++k) \
        acc[ai][bj][m][n] = __builtin_amdgcn_mfma_f32_16x16x32_bf16(Bt[n][k], At[m][k], acc[ai][bj][m][n], 0, 0, 0); __builtin_amdgcn_s_setprio(0); } while (0)
#define PG8_WAIT_V(n) asm volatile("s_waitcnt vmcnt(" #n ")" ::: "memory")
#define PG8_WAIT_L(n) asm volatile("s_waitcnt lgkmcnt(" #n ")" ::: "memory")
#define PG8_BAR __builtin_amdgcn_s_barrier()
#define PG8_SCHED __builtin_amdgcn_sched_barrier(0)
    Unit cur, nxt; int ui = 0;
    if (!S.next(0, cur)) return;
    f32x4 acc[2][2][4][2];
#pragma unroll
    for (int a = 0; a < 2; ++a)
#pragma unroll
        for (int b = 0; b < 2; ++b)
#pragma unroll
            for (int m = 0; m < 4; ++m)
#pragma unroll
                for (int n = 0; n < 2; ++n) acc[a][b][m][n] = (f32x4){0.f, 0.f, 0.f, 0.f};
    bf16x8 At[4][2], B0[2][2], B1[2][2];
    size_t cAo = (size_t)cur.pm * tstepA; const char* cB = (const char*)g.Bt + (size_t)cur.pn * tstepB;
    { const char* a0p = PG8_AK(cAo, 0); const char* a1p = PG8_AK(cAo, 1);
      PG8_STAGE(PG8_SB(0, 0), cB, voffB); PG8_STAGE(PG8_SB(0, 1), cB + hstepB, voffB); PG8_STAGE(PG8_SA(0, 0), a0p, voffA); PG8_STAGE(PG8_SA(0, 1), a0p + hstepA, voffA);
      if (wr == 1) PG8_BAR;
      PG8_WAIT_V(2); PG8_BAR;
      PG8_STAGE(PG8_SB(1, 0), cB + kstep, voffB); PG8_STAGE(PG8_SA(1, 0), a1p, voffA); PG8_STAGE(PG8_SB(1, 1), cB + hstepB + kstep, voffB);
      PG8_WAIT_V(6); PG8_BAR; }
    for (;;) {
        const bool has_next = S.next(ui + 1, nxt);
        const size_t nAo = has_next ? (size_t)nxt.pm * tstepA : cAo; const char* nB = has_next ? (const char*)g.Bt + (size_t)nxt.pn * tstepB : cB;
        for (int t = 0; t < nt; t += 2) {
            const bool last = (t == nt - 2);
            const char* a1 = PG8_AK(cAo, t + 1);
            const char* a2 = last ? PG8_AK(nAo, 0) : PG8_AK(cAo, t + 2); const char* b2 = last ? nB : cB + (size_t)(t + 2) * kstep;
            const char* a3 = last ? PG8_AK(nAo, 1) : PG8_AK(cAo, t + 3); const char* b3 = b2 + kstep;
            PG8_LDB(B0, 0, 0); PG8_LDB(B1, 0, 1); PG8_SCHED; PG8_LDA(At, 0, 0); PG8_STAGE(PG8_SA(1, 1), a1 + hstepA, voffA);
            PG8_WAIT_V(8); PG8_WAIT_L(0); PG8_BAR; PG8_MMA(0, 0, At, B0); PG8_MMA(0, 1, At, B1); PG8_BAR; PG8_SCHED;
            PG8_LDA(At, 0, 1); PG8_STAGE(PG8_SB(0, 0), b2, voffB); PG8_STAGE(PG8_SB(0, 1), b2 + hstepB, voffB); PG8_STAGE(PG8_SA(0, 0), a2, voffA);
            PG8_WAIT_V(8); PG8_WAIT_L(0); PG8_BAR; PG8_MMA(1, 0, At, B0); PG8_MMA(1, 1, At, B1); PG8_BAR; PG8_SCHED;
            PG8_LDB(B0, 1, 0); PG8_LDB(B1, 1, 1); PG8_SCHED; PG8_LDA(At, 1, 0); PG8_STAGE(PG8_SA(0, 1), a2 + hstepA, voffA);
            PG8_WAIT_V(8); PG8_WAIT_L(0); PG8_BAR; PG8_MMA(0, 0, At, B0); PG8_MMA(0, 1, At, B1); PG8_BAR; PG8_SCHED;
            PG8_LDA(At, 1, 1); PG8_STAGE(PG8_SB(1, 0), b3, voffB); PG8_STAGE(PG8_SB(1, 1), b3 + hstepB, voffB); PG8_STAGE(PG8_SA(1, 0), a3, voffA);
            PG8_WAIT_V(8); PG8_WAIT_L(0); PG8_BAR; PG8_MMA(1, 0, At, B0); PG8_MMA(1, 1, At, B1); PG8_BAR; PG8_SCHED;
        }
        if (wr == 0) PG8_BAR;
        E(acc, cur, wr, wc, fr, fq);
        if (!has_next) break;
#pragma unroll
        for (int a = 0; a < 2; ++a)
#pragma unroll
            for (int b = 0; b < 2; ++b)
#pragma unroll
                for (int m = 0; m < 4; ++m)
#pragma unroll
                    for (int n = 0; n < 2; ++n) acc[a][b][m][n] = (f32x4){0.f, 0.f, 0.f, 0.f};
        cur = nxt; cAo = nAo; cB = nB; ++ui;
        if (wr == 1) PG8_BAR;
    }
    PG8_WAIT_V(0);
    PG8_BAR;
#undef PG8_AK
#undef PG8_SA
#undef PG8_SB
#undef PG8_STAGE
#undef PG8_LDA
#undef PG8_LDB
#undef PG8_MMA
#undef PG8_WAIT_V
#undef PG8_WAIT_L
#undef PG8_BAR
#undef PG8_SCHED
}
}

struct EpiP { bf16_t* o0; bf16_t* o1; bf16_t* o2; bf16_t* o3; float* f0; const float* v0; const float* v1; int ldc; float s; };
typedef f32x4 AccT[2][2][4][2];
template <int MODE> struct Epi {
    EpiP p;
    DEV void operator()(const AccT& acc, const pg8::Unit& u, int wr, int wc, int fr, int fq) const {
        const int row0 = u.pm * 256 + wr * 64 + fr;
        const int cl = wc * 32 + 8 * fq;
        if (MODE == 2) {
            u32x4 xv[2][4][2];
#pragma unroll
            for (int ai = 0; ai < 2; ++ai)
#pragma unroll
                for (int m = 0; m < 4; ++m)
#pragma unroll
                    for (int bj = 0; bj < 2; ++bj) xv[ai][m][bj] = *(const u32x4*)(p.o0 + (size_t)(row0 + ai * 128 + m * 16) * 1024 + u.pn * 256 + bj * 128 + cl);
#pragma unroll
            for (int ai = 0; ai < 2; ++ai)
#pragma unroll
                for (int m = 0; m < 4; ++m)
#pragma unroll
                    for (int bj = 0; bj < 2; ++bj) { float x[8]; unpack8(xv[ai][m][bj], x);
#pragma unroll
                        for (int n = 0; n < 2; ++n)
#pragma unroll
                            for (int i = 0; i < 4; ++i) x[n * 4 + i] = 1.41421356237f * x[n * 4 + i] + p.s * acc[ai][bj][m][n][i];
                        *(u32x4*)(p.o0 + (size_t)(row0 + ai * 128 + m * 16) * 1024 + u.pn * 256 + bj * 128 + cl) = pack8(x); }
            return;
        }
#pragma unroll
        for (int ai = 0; ai < 2; ++ai)
#pragma unroll
            for (int m = 0; m < 4; ++m) {
                const size_t row = (size_t)(row0 + ai * 128 + m * 16);
                if (MODE == 1) {
                    float h[8];
#pragma unroll
                    for (int n = 0; n < 2; ++n)
#pragma unroll
                        for (int i = 0; i < 4; ++i) { const float gt = acc[ai][0][m][n][i], up = acc[ai][1][m][n][i]; h[n * 4 + i] = gt * sigmoidf_(gt) * up; }
                    *(u32x4*)(p.o0 + row * 2816 + u.pn * 128 + cl) = pack8(h);
                } else {
#pragma unroll
                    for (int bj = 0; bj < 2; ++bj) {
                        float v[8];
#pragma unroll
                        for (int n = 0; n < 2; ++n)
#pragma unroll
                            for (int i = 0; i < 4; ++i) v[n * 4 + i] = acc[ai][bj][m][n][i];
                        const int col = u.pn * 256 + bj * 128 + cl;
                        if (MODE == 0) {
                            *(u32x4*)(p.o0 + row * p.ldc + col) = pack8(v);
                        } else if (MODE == 2) {
                            bf16_t* xp = p.o0 + row * 1024 + col; float x[8]; unpack8(*(const u32x4*)xp, x);
#pragma unroll
                            for (int i = 0; i < 8; ++i) x[i] = 1.41421356237f * x[i] + p.s * v[i];
                            *(u32x4*)xp = pack8(x);
                        } else if (MODE == 3) {
                            if (u.pn < 12) { bf16_t* base = p.o0 + (size_t)(u.pn >> 2) * E_EL;
                                *(u32x4*)(base + row * 1024 + (col & 1023)) = pack8(v);
                            } else { const int c = bj * 128 + cl;
                                if (bj == 1) {
#pragma unroll
                                    for (int i = 0; i < 8; ++i) v[i] = sigmoidf_(v[i]);
                                } else if (wc < 2) {
#pragma unroll
                                    for (int i = 0; i < 8; ++i) v[i] = tanhf_(v[i]);
                                }
                                *(u32x4*)(p.o3 + row * 256 + c) = pack8(v); }
                        } else if (MODE == 4) {
                            const int c = col & 1023;
                            if (u.pn < 4) {
#pragma unroll
                                for (int i = 0; i < 8; ++i) v[i] = 0.60653066f * sigmoidf_(p.v0[c + i] + v[i]);
                                *(u32x4*)(p.o0 + row * 1024 + c) = pack8(v);
                            } else if (u.pn < 8) {
#pragma unroll
                                for (int i = 0; i < 8; ++i) v[i] = sigmoidf_(p.v1[c + i] + v[i]);
                                *(u32x4*)(p.o1 + row * 1024 + c) = pack8(v);
                            } else *(u32x4*)(p.o2 + row * 1024 + c) = pack8(v);
                        } else if (MODE == 5) {
                            const int which = col >> 10, c = col & 1023, l = which & 1;
                            float* fo = p.f0 + (which < 2 ? O_MK : O_MV) + (size_t)l * 2097152 + row * 1024 + c;
                            *(f32x4*)fo = (f32x4){v[0], v[1], v[2], v[3]}; *(f32x4*)(fo + 4) = (f32x4){v[4], v[5], v[6], v[7]};
                            const int b = (int)(row >> 8), mem = (int)(row & 255);
                            if (which < 2) { *(u32x4*)(p.o0 + ((size_t)(l * 24 + b) * 256 + mem) * 1024 + c) = pack8(v); }
                            else { const int hh = c >> 8, d = c & 255; bf16_t* vt = p.o1 + ((size_t)((l * 24 + b) * 4 + hh) * 256 + d) * 256 + mem;
#pragma unroll
                                for (int i = 0; i < 8; ++i) vt[(size_t)i * 256] = f2bf(v[i]); }
                        }
                    }
                }
            }
    }
};

struct GD { pg8::Gemm g; EpiP ep; int mode; int coff; };
DEV void run_gemm(const GD& d, unsigned char* smem) {
    pg8::StaticOrder S; const int G = gridDim.x; S.init(d.g.M, d.g.N, G, (int)((blockIdx.x + d.coff) % G));
    LAS unsigned char* lds = (LAS unsigned char*)smem;
    switch (d.mode) {
        case 0: { Epi<0> e{d.ep}; pg8::gemm_phase(lds, d.g, S, e); } break;
        case 1: { Epi<1> e{d.ep}; pg8::gemm_phase(lds, d.g, S, e); } break;
        case 2: { Epi<2> e{d.ep}; pg8::gemm_phase(lds, d.g, S, e); } break;
        case 3: { Epi<3> e{d.ep}; pg8::gemm_phase(lds, d.g, S, e); } break;
        case 4: { Epi<4> e{d.ep}; pg8::gemm_phase(lds, d.g, S, e); } break;
        default: { Epi<5> e{d.ep}; pg8::gemm_phase(lds, d.g, S, e); } break;
    }
}

DEV void tconv_tile(const float* src, int ld, int col0, int k0, bf16_t* dst, int ldd, int n0, int kd0, const float* mu, int smode, float* tile) {
    const int tid = ltid();
#pragma unroll
    for (int i = 0; i < 2; ++i) {
        const int kk = (tid >> 4) + 32 * i, c4 = (tid & 15) * 4;
        const f32x4 v = *(const f32x4*)(src + (size_t)(k0 + kk) * ld + col0 + c4);
        float sc = 1.f; if (smode) { const float m = mu[k0 + kk]; sc = (smode == 1) ? (1.f - m) : m; }
        tile[kk * 65 + c4 + 0] = v[0] * sc; tile[kk * 65 + c4 + 1] = v[1] * sc; tile[kk * 65 + c4 + 2] = v[2] * sc; tile[kk * 65 + c4 + 3] = v[3] * sc;
    }
    __syncthreads();
    const int nn = tid >> 3, kc = (tid & 7) * 8;
    u32x4 o; o.x = pk2(tile[(kc + 0) * 65 + nn], tile[(kc + 1) * 65 + nn]); o.y = pk2(tile[(kc + 2) * 65 + nn], tile[(kc + 3) * 65 + nn]);
    o.z = pk2(tile[(kc + 4) * 65 + nn], tile[(kc + 5) * 65 + nn]); o.w = pk2(tile[(kc + 6) * 65 + nn], tile[(kc + 7) * 65 + nn]);
    *(u32x4*)(dst + (size_t)(n0 + nn) * ldd + kd0 + kc) = o;
    __syncthreads();
}
DEV void tconv_mat(const float* src, int ld, int K, int N, bf16_t* dst, int ldd, int kd0, int cmap, const float* mu, int smode, float* tile, int& base, int vb, int G) {
    const int nkb = K / 64, nt = nkb * (N / 64);
    const int start = (int)((vb + G - (base % G)) % G);
    for (int t = start; t < nt; t += G) {
        const int nb = t / nkb, kb = t % nkb; int col0 = nb * 64;
        if (cmap == 1) { const int pn = nb >> 2, bj = (nb >> 1) & 1, jb = nb & 1; col0 = bj * 2816 + pn * 128 + jb * 64; }
        tconv_tile(src, ld, col0, kb * 64, dst, ldd, nb * 64, kd0 + kb * 64, mu, smode, tile);
    }
    base += nt;
}
DEV void cvt_flat(const float* src, bf16_t* dst, size_t n8, int vb, int G) {
    for (size_t i = (size_t)vb * NTHR + ltid(); i < n8; i += (size_t)G * NTHR) {
        const f32x4 a = *(const f32x4*)(src + i * 8), b = *(const f32x4*)(src + i * 8 + 4);
        u32x4 o; o.x = pk2(a[0], a[1]); o.y = pk2(a[2], a[3]); o.z = pk2(b[0], b[1]); o.w = pk2(b[2], b[3]);
        *(u32x4*)(dst + i * 8) = o;
    }
}
DEV void prep_phase(const KP& P, unsigned char* smem, int part, int vb, int G) {
    float* tile = (float*)smem; bf16_t* W = (bf16_t*)P.ws; int base = 0;
    bf16_t* VT = (bf16_t*)(P.ws + WS_VT); bf16_t* KB = (bf16_t*)(P.ws + WS_KB);
#define TC(...) tconv_mat(__VA_ARGS__, tile, base, vb, G)
    for (int i = 2 * part; i < 2 * part + 2; ++i) TC(PIN(12) + (size_t)i * 1024 * 5632, 5632, 1024, 5632, W + W_UP + (size_t)i * 5632 * 1024, 1024, 0, 1, nullptr, 0);
    for (int i = 2 * part; i < 2 * part + 2; ++i) TC(PIN(13) + (size_t)i * 2816 * 1024, 1024, 2816, 1024, W + W_DN + (size_t)i * 1024 * 2816, 2816, 0, 0, nullptr, 0);
    { const int l = part;
        TC(PIN(14) + (size_t)l * 1048576, 1024, 1024, 1024, W + W_XQ + (size_t)l * 1048576, 1024, 0, 0, nullptr, 0);
        TC(PIN(17) + (size_t)l * 1048576, 1024, 1024, 1024, W + W_XO + (size_t)l * 1048576, 1024, 0, 0, nullptr, 0); }
    if (part == 0) {
        for (int l = 0; l < 2; ++l) {
            TC(PIN(15) + (size_t)l * 1048576, 1024, 1024, 1024, W + W_KV + (size_t)l * 1048576, 1024, 0, 0, nullptr, 0);
            TC(PIN(16) + (size_t)l * 1048576, 1024, 1024, 1024, W + W_KV + (size_t)(2 + l) * 1048576, 1024, 0, 0, nullptr, 0); }
        TC(PIN(18), 3072, 1024, 3072, W + W_IN, 1024, 0, 0, nullptr, 0);
        TC(PIN(28), 1024, 1024, 1024, W + W_O0, 1024, 0, 0, nullptr, 0);
    } else {
        for (int p = 0; p < 3; ++p) {
            TC(PIN(30) + (size_t)p * 1048576, 1024, 1024, 1024, W + W_P1 + (size_t)p * 1024 * 2048, 2048, 0, 0, PIN(29) + p * 1024, 1);
            TC(PIN(30) + (size_t)p * 1048576, 1024, 1024, 1024, W + W_P1 + (size_t)p * 1024 * 2048, 2048, 1024, 0, PIN(29) + p * 1024, 2); }
        TC(PIN(32), 64, 1024, 64, W + W_P1 + (size_t)3072 * 2048, 2048, 0, 0, PIN(29) + 3 * 1024, 1);
        TC(PIN(32), 64, 1024, 64, W + W_P1 + (size_t)3072 * 2048, 2048, 1024, 0, PIN(29) + 3 * 1024, 2);
        TC(PIN(35), 64, 1024, 64, W + W_P1 + (size_t)3136 * 2048, 2048, 0, 0, PIN(29) + 4 * 1024, 1);
        TC(PIN(35), 64, 1024, 64, W + W_P1 + (size_t)3136 * 2048, 2048, 1024, 0, PIN(29) + 4 * 1024, 2);
        TC(PIN(37), 128, 1024, 128, W + W_P1 + (size_t)3200 * 2048, 2048, 0, 0, PIN(29) + 5 * 1024, 1);
        TC(PIN(37), 128, 1024, 128, W + W_P1 + (size_t)3200 * 2048, 2048, 1024, 0, PIN(29) + 5 * 1024, 2);
        TC(PIN(44), 1024, 1024, 1024, W + W_O1, 1024, 0, 0, nullptr, 0);
    }
    for (int j = 64 * part; j < 64 * part + 64; ++j) { const int l = j >> 6, b = (j >> 2) & 15, h = j & 3;
        TC(PIN(9) + (size_t)((l * 16 + b) * 256) * 1024 + h * 256, 1024, 256, 256, VT + (size_t)((l * 24 + 8 + b) * 4 + h) * 65536, 256, 0, 0, nullptr, 0); }
#undef TC
    { const int l = part; cvt_flat(PIN(8) + (size_t)l * 16 * 256 * 1024, KB + (size_t)(l * 24 + 8) * 256 * 1024, (size_t)16 * 256 * 1024 / 8, vb, G); }
    if (part == 0) {
        bf16_t* XB = (bf16_t*)(P.ws + WS_XB);
        cvt_flat(PIN(0), XB, (size_t)MPROMPT * 1024 / 8, vb, G);
        cvt_flat(PIN(1), XB + (size_t)MPROMPT * 1024, (size_t)512 * 1024 / 8, vb, G);
        cvt_flat(PIN(2), (bf16_t*)(P.ws + WS_A4), (size_t)2048 * 1024 / 8, vb, G);
    } else {
        for (int i = vb * NTHR + ltid(); i < 3072 * 32; i += G * NTHR) {
            const int n = i >> 5, kc = (i & 31) * 8; float v[8];
#pragma unroll
            for (int j = 0; j < 8; ++j) { const int k = kc + j; float x = 0.f;
                if (n < 1024) { if (k < 64) x = PIN(33)[(size_t)k * 1024 + n]; }
                else if (n < 2048) { if (k >= 64 && k < 128) x = PIN(36)[(size_t)(k - 64) * 1024 + (n - 1024)]; }
                else { if (k >= 128) x = PIN(38)[(size_t)(k - 128) * 1024 + (n - 2048)]; }
                v[j] = x; }
            *(u32x4*)(W + W_L2 + (size_t)n * 256 + kc) = pack8(v);
        }
    }
}

DEV void ln_phase(bf16_t* X, const float* g, const float* b, bf16_t* Xp, float* outf, const float* shift_in, float* outbase, bool dry) {
    const int lane = ltid() & 63, wave = ltid() >> 6;
    float gg[16], bb[16];
#pragma unroll
    for (int j = 0; j < 8; ++j) { gg[j] = g[lane * 8 + j]; gg[8 + j] = g[512 + lane * 8 + j]; bb[j] = b[lane * 8 + j]; bb[8 + j] = b[512 + lane * 8 + j]; }
    u32x4 na = (u32x4){0u, 0u, 0u, 0u}, nb = na;
    { const int r0 = blockIdx.x * 8 + wave; if (r0 < MTOK) { na = *(const u32x4*)(X + (size_t)r0 * 1024 + lane * 8); nb = *(const u32x4*)(X + (size_t)r0 * 1024 + 512 + lane * 8); } }
    for (int row = blockIdx.x * 8 + wave; row < MTOK; row += gridDim.x * 8) {
        bf16_t* xr = X + (size_t)row * 1024;
        float v[16]; unpack8(na, v); unpack8(nb, v + 8);
        { const int nr = row + gridDim.x * 8; if (nr < MTOK) { na = *(const u32x4*)(X + (size_t)nr * 1024 + lane * 8); nb = *(const u32x4*)(X + (size_t)nr * 1024 + 512 + lane * 8); } }
        float s = 0.f;
#pragma unroll
        for (int j = 0; j < 16; ++j) s += v[j];
        const float mean = wave_sum(s) * (1.f / 1024.f); float s2 = 0.f;
#pragma unroll
        for (int j = 0; j < 16; ++j) { v[j] -= mean; s2 += v[j] * v[j]; }
        const float rstd = rsqrtf(wave_sum(s2) * (1.f / 1024.f) + 1e-5f);
#pragma unroll
        for (int j = 0; j < 16; ++j) v[j] = v[j] * rstd * gg[j] + bb[j];
        const u32x4 o0 = pack8(v), o1 = pack8(v + 8);
        if (!dry) { *(u32x4*)(xr + lane * 8) = o0; *(u32x4*)(xr + 512 + lane * 8) = o1; }
        if (outf) { float* fo = outf + (size_t)row * 1024;
#pragma unroll
            for (int j = 0; j < 16; ++j) v[j] *= DBG_YSCALE;
            *(f32x4*)(fo + lane * 8) = (f32x4){v[0], v[1], v[2], v[3]}; *(f32x4*)(fo + lane * 8 + 4) = (f32x4){v[4], v[5], v[6], v[7]};
            *(f32x4*)(fo + 512 + lane * 8) = (f32x4){v[8], v[9], v[10], v[11]}; *(f32x4*)(fo + 512 + lane * 8 + 4) = (f32x4){v[12], v[13], v[14], v[15]}; }
        if (Xp) {
            int t, T, bidx; const bool prompt = row < MPROMPT;
            if (prompt) { bidx = row >> 12; t = row & 4095; T = 4096; } else { const int r2 = row - MPROMPT; bidx = r2 >> 5; t = r2 & 31; T = 32; }
            if (t + 1 < T) { bf16_t* xn = Xp + (size_t)(row + 1) * 1024; *(u32x4*)(xn + lane * 8) = o0; *(u32x4*)(xn + 512 + lane * 8) = o1; }
            else { float* so = outbase + (prompt ? O_PSHIFT : O_SSHIFT) + (size_t)bidx * 1024;
#pragma unroll
                for (int j = 0; j < 16; ++j) v[j] *= DBG_SHSCALE;
                *(f32x4*)(so + lane * 8) = (f32x4){v[0], v[1], v[2], v[3]}; *(f32x4*)(so + lane * 8 + 4) = (f32x4){v[4], v[5], v[6], v[7]};
                *(f32x4*)(so + 512 + lane * 8) = (f32x4){v[8], v[9], v[10], v[11]}; *(f32x4*)(so + 512 + lane * 8 + 4) = (f32x4){v[12], v[13], v[14], v[15]}; }
            if (t == 0) { bf16_t* x0 = Xp + (size_t)row * 1024; float z[16];
#pragma unroll
                for (int j = 0; j < 8; ++j) { z[j] = prompt ? 0.f : shift_in[(size_t)bidx * 1024 + lane * 8 + j]; z[8 + j] = prompt ? 0.f : shift_in[(size_t)bidx * 1024 + 512 + lane * 8 + j]; }
                *(u32x4*)(x0 + lane * 8) = pack8(z); *(u32x4*)(x0 + 512 + lane * 8) = pack8(z + 8); }
        }
    }
}

DEV void attn_phase(const bf16_t* Q, const bf16_t* KBl, const bf16_t* VTl, bf16_t* AO, unsigned char* smem) {
    const int tid = ltid(), lane = tid & 63, wave = tid >> 6, fr = lane & 15, g = lane >> 4;
    bf16_t* Ks = (bf16_t*)smem;
    bf16_t* Vs = (bf16_t*)(smem + 64 * 264 * 2);
    for (int job = blockIdx.x; job < 1088; job += gridDim.x) {
        int s, h, row0, nvalid;
        if (job < 1024) { s = job >> 7; h = (job >> 5) & 3; row0 = s * 4096 + (job & 31) * 128; nvalid = 128; }
        else { const int j2 = job - 1024; s = 8 + (j2 >> 2); h = j2 & 3; row0 = MPROMPT + (s - 8) * 32; nvalid = 32; }
        const int myrow = wave * 16 + fr; const bool valid = myrow < nvalid;
        const bf16_t* qp = Q + (size_t)(row0 + (valid ? myrow : 0)) * 1024 + h * 256 + g * 8;
        bf16x8 qf[8];
#pragma unroll
        for (int s8 = 0; s8 < 8; ++s8) qf[s8] = *(const bf16x8*)(qp + s8 * 32);
        f32x4 sc[16];
#pragma unroll
        for (int i = 0; i < 16; ++i) sc[i] = (f32x4){0.f, 0.f, 0.f, 0.f};
        const bf16_t* Kg = KBl + (size_t)s * 256 * 1024 + h * 256;
        const bf16_t* Vg = VTl + (size_t)(s * 4 + h) * 65536;
        u32x4 pre[4];
#pragma unroll
        for (int i = 0; i < 4; ++i) { const int ch = tid + i * 512, key = ch >> 5, dc = (ch & 31) * 8; pre[i] = *(const u32x4*)(Kg + (size_t)key * 1024 + dc); }
#pragma unroll
        for (int kt4 = 0; kt4 < 4; ++kt4) {
            __syncthreads();
#pragma unroll
            for (int i = 0; i < 4; ++i) { const int ch = tid + i * 512, key = ch >> 5, dc = (ch & 31) * 8; *(u32x4*)(Ks + key * 264 + dc) = pre[i]; }
            __syncthreads();
            if (kt4 < 3) {
#pragma unroll
                for (int i = 0; i < 4; ++i) { const int ch = tid + i * 512, key = ch >> 5, dc = (ch & 31) * 8; pre[i] = *(const u32x4*)(Kg + (size_t)((kt4 + 1) * 64 + key) * 1024 + dc); }
            } else {
#pragma unroll
                for (int i = 0; i < 4; ++i) { const int ch = tid + i * 512, d = ch >> 3, kc = (ch & 7) * 8; pre[i] = *(const u32x4*)(Vg + (size_t)d * 256 + kc); }
            }
#pragma unroll
            for (int kt = 0; kt < 4; ++kt)
#pragma unroll
                for (int s8 = 0; s8 < 8; ++s8) { const bf16x8 kf = *(const bf16x8*)(Ks + (kt * 16 + fr) * 264 + s8 * 32 + g * 8);
                    sc[kt4 * 4 + kt] = mfma16(kf, qf[s8], sc[kt4 * 4 + kt]); }
        }
        float mx = -3.0e38f;
#pragma unroll
        for (int i = 0; i < 16; ++i)
#pragma unroll
            for (int r = 0; r < 4; ++r) mx = fmaxf(mx, sc[i][r]);
        mx = fmaxf(mx, __shfl_xor(mx, 16)); mx = fmaxf(mx, __shfl_xor(mx, 32));
        float sum = 0.f;
#pragma unroll
        for (int i = 0; i < 16; ++i)
#pragma unroll
            for (int r = 0; r < 4; ++r) { const float pv = exp2f((sc[i][r] - mx) * (0.0625f * 1.44269504f)); sc[i][r] = pv; sum += pv; }
        sum += __shfl_xor(sum, 16); sum += __shfl_xor(sum, 32);
        bf16x8 pf[8];
#pragma unroll
        for (int s2 = 0; s2 < 8; ++s2) { u32x4 o; o.x = pk2(sc[2 * s2][0], sc[2 * s2][1]); o.y = pk2(sc[2 * s2][2], sc[2 * s2][3]);
            o.z = pk2(sc[2 * s2 + 1][0], sc[2 * s2 + 1][1]); o.w = pk2(sc[2 * s2 + 1][2], sc[2 * s2 + 1][3]); pf[s2] = __builtin_bit_cast(bf16x8, o); }
        f32x4 oa[16];
#pragma unroll
        for (int i = 0; i < 16; ++i) oa[i] = (f32x4){0.f, 0.f, 0.f, 0.f};
#pragma unroll
        for (int vt4 = 0; vt4 < 4; ++vt4) {
            __syncthreads();
#pragma unroll
            for (int i = 0; i < 4; ++i) { const int ch = tid + i * 512, d = ch >> 3, kc = (ch & 7) * 8; *(u32x4*)(Vs + d * 72 + kc) = pre[i]; }
            __syncthreads();
            if (vt4 < 3) {
#pragma unroll
                for (int i = 0; i < 4; ++i) { const int ch = tid + i * 512, d = ch >> 3, kc = (ch & 7) * 8; pre[i] = *(const u32x4*)(Vg + (size_t)d * 256 + (vt4 + 1) * 64 + kc); }
            }
#pragma unroll
            for (int s2l = 0; s2l < 2; ++s2l)
#pragma unroll
                for (int dt = 0; dt < 16; ++dt) {
                    const bf16_t* vp = Vs + (dt * 16 + fr) * 72 + 32 * s2l + 4 * g;
                    const u32x2 lo = *(const u32x2*)vp, hi = *(const u32x2*)(vp + 16);
                    u32x4 c; c.x = lo.x; c.y = lo.y; c.z = hi.x; c.w = hi.y;
                    oa[dt] = mfma16(__builtin_bit_cast(bf16x8, c), pf[vt4 * 2 + s2l], oa[dt]);
                }
        }
        const float inv = 1.f / sum;
        if (valid) { bf16_t* op = AO + (size_t)(row0 + myrow) * 1024 + h * 256 + 4 * g;
#pragma unroll
            for (int dt = 0; dt < 16; ++dt) { u32x2 o; o.x = pk2(oa[dt][0] * inv, oa[dt][1] * inv); o.y = pk2(oa[dt][2] * inv, oa[dt][3] * inv); *(u32x2*)(op + dt * 16) = o; } }
    }
}

DEV void ret_job(int s, int h, const KP& P, const bf16_t* PB, bf16_t* YM, unsigned char* smem) {
    const int tid = ltid(), lane = tid & 63, w = tid >> 6, fr = lane & 15, g = lane >> 4;
    const bool prompt = s < 8; const int T = prompt ? 4096 : 32, C = prompt ? DBG_C_RET : 32, nch = T / C;
    const int row0 = prompt ? s * 4096 : MPROMPT + (s - 8) * 32, pos0 = prompt ? 0 : 4096;
    const float log2g = log2f(1.f - exp2f(-5.f - (float)h));
    const float cdecay = exp2f(log2g * (float)C);
    bf16_t* Qs = (bf16_t*)smem;
    bf16_t* Ks = (bf16_t*)(smem + 17408);
    bf16_t* Kt = (bf16_t*)(smem + 34816);
    bf16_t* Vt = (bf16_t*)(smem + 53248);
    bf16_t* St = (bf16_t*)(smem + 71680);
    bf16_t* Ps = (bf16_t*)(smem + 106496);
    float* Os = (float*)smem;
    const float* st_in = prompt ? nullptr : PIN(5) + (size_t)((s - 8) * 4 + h) * 16384;
    float* st_out = P.out + (prompt ? O_PRET + (size_t)(s * 4 + h) * 16384 : O_SRET + (size_t)((s - 8) * 4 + h) * 16384);
    f32x4 Sacc[8];
#pragma unroll
    for (int dvt = 0; dvt < 8; ++dvt)
#pragma unroll
        for (int r = 0; r < 4; ++r) Sacc[dvt][r] = st_in ? st_in[(size_t)(16 * w + 4 * g + r) * 128 + dvt * 16 + fr] : 0.f;
    __syncthreads();
    for (int i = tid; i < 71680 / 16; i += NTHR) ((u32x4*)smem)[i] = (u32x4){0u, 0u, 0u, 0u};
#pragma unroll
    for (int dvt = 0; dvt < 8; ++dvt) { u32x2 o; o.x = pk2(Sacc[dvt][0], Sacc[dvt][1]); o.y = pk2(Sacc[dvt][2], Sacc[dvt][3]);
        *(u32x2*)(St + (dvt * 16 + fr) * 136 + 16 * w + 4 * g) = o; }
    __syncthreads();
    const float* gng = PIN(26) + h * 128; const float* gnb = PIN(27) + h * 128;
    u32x4 pq1 = (u32x4){0u, 0u, 0u, 0u}, pq2 = pq1, pk1 = pq1, pk2r = pq1, pv0 = pq1, pv1 = pq1, pg0 = pq1, pg1 = pq1;
#define RET_LOAD(ch_) do { const bf16_t* bp_ = PB + (size_t)(row0 + (ch_) * C + (tid >> 3)) * 3072 + h * 128; const int sg_ = tid & 7; \
        pq1 = *(const u32x4*)(bp_ + 1024 + sg_ * 8); pq2 = *(const u32x4*)(bp_ + 1024 + 64 + sg_ * 8); pk1 = *(const u32x4*)(bp_ + 1536 + sg_ * 8); pk2r = *(const u32x4*)(bp_ + 1536 + 64 + sg_ * 8); \
        pv0 = *(const u32x4*)(bp_ + 2048 + sg_ * 16); pv1 = *(const u32x4*)(bp_ + 2048 + sg_ * 16 + 8); } while (0)
    if ((tid >> 3) < C) RET_LOAD(0);
    for (int ch = 0; ch < nch; ++ch) {
        {
            const int t = tid >> 3, seg = tid & 7;
            if (t < C) {
                float q1[8], q2[8], k1[8], k2[8];
                unpack8(pq1, q1); unpack8(pq2, q2); unpack8(pk1, k1); unpack8(pk2r, k2);
                const u32x4 v0 = pv0, v1 = pv1;
                const float pos = (float)(pos0 + ch * C + t);
                const float zeta = exp2f(log2g * (float)(C - 1 - t));
                float qa[8], qb[8], ka[8], kb[8];
#pragma unroll
                for (int j = 0; j < 8; ++j) {
                    const int d = seg * 8 + j;
                    const float invf = exp2f(-(float)d * (13.287712379549449f / 64.f));
                    const float rev = pos * invf * 0.15915494309189535f; const float frc = rev - floorf(rev);
                    const float sn = __builtin_amdgcn_sinf(frc), cs = __builtin_amdgcn_cosf(frc);
                    qa[j] = q1[j] * cs - q2[j] * sn; qb[j] = q1[j] * sn + q2[j] * cs;
                    ka[j] = (k1[j] * cs - k2[j] * sn) * 0.08838834764831845f; kb[j] = (k1[j] * sn + k2[j] * cs) * 0.08838834764831845f;
                    Kt[d * 72 + t] = f2bf(ka[j] * zeta); Kt[(64 + d) * 72 + t] = f2bf(kb[j] * zeta);
                }
                *(u32x4*)(Qs + t * 136 + seg * 8) = pack8(qa); *(u32x4*)(Qs + t * 136 + 64 + seg * 8) = pack8(qb);
                *(u32x4*)(Ks + t * 136 + seg * 8) = pack8(ka); *(u32x4*)(Ks + t * 136 + 64 + seg * 8) = pack8(kb);
                const unsigned vv[8] = {v0.x, v0.y, v0.z, v0.w, v1.x, v1.y, v1.z, v1.w};
#pragma unroll
                for (int j = 0; j < 8; ++j) { Vt[(seg * 16 + 2 * j) * 72 + t] = (bf16_t)(vv[j] & 0xffffu); Vt[(seg * 16 + 2 * j + 1) * 72 + t] = (bf16_t)(vv[j] >> 16); }
                { const bf16_t* gp_ = PB + (size_t)(row0 + ch * C + t) * 3072 + 2560 + h * 128 + seg * 16; pg0 = *(const u32x4*)gp_; pg1 = *(const u32x4*)(gp_ + 8); }
                if (ch + 1 < nch) RET_LOAD(ch + 1);
            }
        }
        __syncthreads();
        {
            const int jt = w & 3;
#pragma unroll
            for (int x = 0; x < 2; ++x) {
                const int it = 2 * (w >> 2) + x; f32x4 a = (f32x4){0.f, 0.f, 0.f, 0.f};
#pragma unroll
                for (int s4 = 0; s4 < 4; ++s4) a = mfma16(*(const bf16x8*)(Ks + (jt * 16 + fr) * 136 + s4 * 32 + g * 8), *(const bf16x8*)(Qs + (it * 16 + fr) * 136 + s4 * 32 + g * 8), a);
                const int i = it * 16 + fr; float pr[4];
#pragma unroll
                for (int r = 0; r < 4; ++r) { const int j = jt * 16 + 4 * g + r; pr[r] = (i >= j) ? a[r] * exp2f(log2g * (float)(i - j)) : 0.f; }
                u32x2 o; o.x = pk2(pr[0], pr[1]); o.y = pk2(pr[2], pr[3]);
                *(u32x2*)(Ps + i * 72 + jt * 16 + 4 * g) = o;
            }
        }
        __syncthreads();
        f32x4 oacc[4];
        {
            const int it = w & 3;
#pragma unroll
            for (int x = 0; x < 4; ++x) {
                const int dvt = 4 * (w >> 2) + x; f32x4 a = (f32x4){0.f, 0.f, 0.f, 0.f};
#pragma unroll
                for (int s4 = 0; s4 < 4; ++s4) a = mfma16(*(const bf16x8*)(Qs + (it * 16 + fr) * 136 + s4 * 32 + g * 8), *(const bf16x8*)(St + (dvt * 16 + fr) * 136 + s4 * 32 + g * 8), a);
#pragma unroll
                for (int r = 0; r < 4; ++r) a[r] *= exp2f(log2g * (float)(it * 16 + 4 * g + r + 1));
#pragma unroll
                for (int s2 = 0; s2 < 2; ++s2) a = mfma16(*(const bf16x8*)(Ps + (it * 16 + fr) * 72 + s2 * 32 + g * 8), *(const bf16x8*)(Vt + (dvt * 16 + fr) * 72 + s2 * 32 + g * 8), a);
                oacc[x] = a;
            }
#pragma unroll
            for (int dvt = 0; dvt < 8; ++dvt) {
                f32x4 a = Sacc[dvt] * cdecay;
#pragma unroll
                for (int s2 = 0; s2 < 2; ++s2) a = mfma16(*(const bf16x8*)(Kt + (16 * w + fr) * 72 + s2 * 32 + g * 8), *(const bf16x8*)(Vt + (dvt * 16 + fr) * 72 + s2 * 32 + g * 8), a);
                Sacc[dvt] = a;
            }
        }
        __syncthreads();
        {
            const int it = w & 3;
#pragma unroll
            for (int x = 0; x < 4; ++x) { const int dvt = 4 * (w >> 2) + x;
#pragma unroll
                for (int r = 0; r < 4; ++r) Os[(it * 16 + 4 * g + r) * 132 + dvt * 16 + fr] = oacc[x][r]; }
#pragma unroll
            for (int dvt = 0; dvt < 8; ++dvt) { u32x2 o; o.x = pk2(Sacc[dvt][0], Sacc[dvt][1]); o.y = pk2(Sacc[dvt][2], Sacc[dvt][3]);
                *(u32x2*)(St + (dvt * 16 + fr) * 136 + 16 * w + 4 * g) = o; }
        }
        __syncthreads();
        {
            const int i = tid >> 3, seg = tid & 7; float o[16]; float sm = 0.f;
#pragma unroll
            for (int j = 0; j < 16; ++j) { o[j] = Os[i * 132 + seg * 16 + j]; sm += o[j]; }
            const float mean = red8(sm) * (1.f / 128.f); float s2 = 0.f;
#pragma unroll
            for (int j = 0; j < 16; ++j) { o[j] -= mean; s2 += o[j] * o[j]; }
            const float rstd = rsqrtf(red8(s2) * (1.f / 128.f) + 1e-5f);
            if (i < C) {
                const size_t row = (size_t)(row0 + ch * C + i);
                float gt[16]; unpack8(pg0, gt); unpack8(pg1, gt + 8);
#pragma unroll
                for (int j = 0; j < 16; ++j) { const float y = o[j] * rstd * gng[seg * 16 + j] + gnb[seg * 16 + j]; o[j] = y * gt[j] * sigmoidf_(gt[j]); }
                *(u32x4*)(YM + row * 1024 + 512 + h * 128 + seg * 16) = pack8(o); *(u32x4*)(YM + row * 1024 + 512 + h * 128 + seg * 16 + 8) = pack8(o + 8);
            }
        }
        __syncthreads();
    }
#pragma unroll
    for (int dvt = 0; dvt < 8; ++dvt)
#pragma unroll
        for (int r = 0; r < 4; ++r) st_out[(size_t)(16 * w + 4 * g + r) * 128 + dvt * 16 + fr] = Sacc[dvt][r] * DBG_RETSCALE;
}

DEV void lru_job(int s, int gb, const KP& P, const bf16_t* PB, bf16_t* YM, unsigned char* smem) {
    const int tid = ltid(), lane = tid & 63, w = tid >> 6, fr = lane & 15, g = lane >> 4;
    const bool prompt = s < 8; const int T = prompt ? 4096 : 32, C = prompt ? DBG_C : 32, nch = T / C;
    const int row0 = prompt ? s * 4096 : MPROMPT + (s - 8) * 32, bidx = prompt ? s : s - 8;
    bf16_t* Wt = (bf16_t*)smem;
    bf16_t* Xc = (bf16_t*)(smem + 18432);
    float* Xr = (float*)(smem + 27648);
    float* GA = (float*)(smem + 44800);
    float* GI = (float*)(smem + 61440);
    __syncthreads();
    for (int i = tid; i < 128 * 64; i += NTHR) { const int co = i >> 6, ci = i & 63;
        const float* wsrc = (co < 64) ? PIN(21) : PIN(23);
        Wt[co * 72 + ci] = f2bf(wsrc[(size_t)gb * 4096 + ci * 64 + (co & 63)]); }
    for (int i = tid; i < 64 * 72 / 2; i += NTHR) ((unsigned*)Xc)[i] = 0u;
    if (tid < 192) { const int j = tid >> 6, c = tid & 63; Xr[j * 64 + c] = prompt ? 0.f : PIN(3)[(size_t)(bidx * 3 + j) * 512 + gb * 64 + c]; }
    const int t = tid >> 3, seg = tid & 7, c0 = gb * 64 + seg * 8;
    float cw[4][8], cb[8], spl[8];
#pragma unroll
    for (int j = 0; j < 8; ++j) { cb[j] = PIN(20)[c0 + j]; const float lam = PIN(25)[c0 + j]; spl[j] = -8.f * log1pf(__expf(-lam));
#pragma unroll
        for (int q = 0; q < 4; ++q) cw[q][j] = PIN(19)[q * 512 + c0 + j]; }
    float* SUMS = (float*)(smem + 78080);
    float* HC = (float*)(smem + 82176);
    if (tid < 64) HC[tid] = prompt ? 0.f : PIN(4)[(size_t)bidx * 512 + gb * 64 + tid];
    const float* bias_g = (w < 4) ? PIN(22) : PIN(24);
    __syncthreads();
    u32x4 px = (u32x4){0u, 0u, 0u, 0u}, pga = px;
    if (t < C) px = *(const u32x4*)(PB + (size_t)(row0 + t) * 3072 + c0);
    for (int ch = 0; ch < nch; ++ch) {
        if (t < C) { float x[8]; unpack8(px, x);
#pragma unroll
            for (int j = 0; j < 8; ++j) Xr[(3 + t) * 64 + seg * 8 + j] = x[j];
            pga = *(const u32x4*)(PB + (size_t)(row0 + ch * C + t) * 3072 + 512 + c0);
            if (ch + 1 < nch) px = *(const u32x4*)(PB + (size_t)(row0 + (ch + 1) * C + t) * 3072 + c0); }
        __syncthreads();
        float xc[8];
#pragma unroll
        for (int j = 0; j < 8; ++j) xc[j] = 0.f;
        if (t < C) {
#pragma unroll
            for (int j = 0; j < 8; ++j) { float a = cb[j];
#pragma unroll
                for (int q = 0; q < 4; ++q) a += cw[q][j] * Xr[(t + q) * 64 + seg * 8 + j];
                xc[j] = a; }
            *(u32x4*)(Xc + t * 72 + seg * 8) = pack8(xc);
        }
        __syncthreads();
        {
            const int tt = w & 3;
#pragma unroll
            for (int x = 0; x < 4; ++x) { const int cot = 4 * (w >> 2) + x; f32x4 a = (f32x4){0.f, 0.f, 0.f, 0.f};
#pragma unroll
                for (int s2 = 0; s2 < 2; ++s2) a = mfma16(*(const bf16x8*)(Xc + (tt * 16 + fr) * 72 + s2 * 32 + g * 8), *(const bf16x8*)(Wt + (cot * 16 + fr) * 72 + s2 * 32 + g * 8), a);
                const int co = (cot & 3) * 16 + fr; const float bs = bias_g[gb * 64 + co]; float* dst = (w < 4) ? GA : GI;
#pragma unroll
                for (int r = 0; r < 4; ++r) dst[(tt * 16 + 4 * g + r) * 65 + co] = sigmoidf_(a[r] + bs); }
        }
        __syncthreads();
        if (t < C) {
#pragma unroll
            for (int j = 0; j < 8; ++j) { const int c = seg * 8 + j; const float rg = GA[t * 65 + c], ig = GI[t * 65 + c];
                const float la = spl[j] * rg, a = __expf(la); const float mult = sqrtf(fmaxf(1.f - a * a, 0.f));
                GA[t * 65 + c] = a; GI[t * 65 + c] = mult * (ig * xc[j]); }
        }
        __syncthreads();
        {
            const int SEG = C >> 3, wu = __builtin_amdgcn_readfirstlane(w);
            float pl[8], hl[8]; float pp = 1.f, hh = 0.f;
#pragma unroll
            for (int j = 0; j < 8; ++j) if (j < SEG) { const int tt = wu * SEG + j; const float a_ = GA[tt * 65 + lane], u_ = GI[tt * 65 + lane]; hh = a_ * hh + u_; pp *= a_; hl[j] = hh; pl[j] = pp; }
            SUMS[(wu * 64 + lane) * 2] = pp; SUMS[(wu * 64 + lane) * 2 + 1] = hh;
            if (wu == 1) { const float r0 = Xr[(C + 0) * 64 + lane], r1 = Xr[(C + 1) * 64 + lane], r2 = Xr[(C + 2) * 64 + lane];
                Xr[lane] = r0; Xr[64 + lane] = r1; Xr[128 + lane] = r2; }
            __syncthreads();
            float carry = HC[lane];
            for (int w2 = 0; w2 < wu; ++w2) carry = SUMS[(w2 * 64 + lane) * 2] * carry + SUMS[(w2 * 64 + lane) * 2 + 1];
#pragma unroll
            for (int j = 0; j < 8; ++j) if (j < SEG) GI[(wu * SEG + j) * 65 + lane] = hl[j] + pl[j] * carry;
            const float ncar = pp * carry + hh;
            __syncthreads();
            if (wu == 7) HC[lane] = ncar;
        }
        if (t < C) { const size_t row = (size_t)(row0 + ch * C + t); float ga[8]; unpack8(pga, ga); float y[8];
#pragma unroll
            for (int j = 0; j < 8; ++j) { const float x = ga[j]; const float ge = 0.5f * x * (1.f + tanhf_(0.7978845608f * (x + 0.044715f * x * x * x))); y[j] = GI[t * 65 + seg * 8 + j] * ge; }
            *(u32x4*)(YM + row * 1024 + c0) = pack8(y); }
        __syncthreads();
    }
    if (tid < 64) P.out[(prompt ? O_PLRU : O_SLRU) + (size_t)bidx * 512 + gb * 64 + tid] = HC[tid] * DBG_LRUSCALE;
    if (tid < 192) { const int j = tid >> 6, c = tid & 63; P.out[(prompt ? O_PCONV : O_SCONV) + (size_t)(bidx * 3 + j) * 512 + gb * 64 + c] = Xr[j * 64 + c] * DBG_CONVSCALE; }
    __syncthreads();
}

DEV void wkv_job(int s, int h, const KP& P, bf16_t* RO, const bf16_t* Kk, const bf16_t* Vv, const bf16_t* Ee, const bf16_t* Aa, const bf16_t* Gg, unsigned char* smem, bool dry) {
    const int tid = ltid(), q = tid & 15, rp = tid >> 4;
    const bool prompt = s < 8; const int T = prompt ? 4096 : 32, nch = T / 32;
    const int row0 = prompt ? s * 4096 : MPROMPT + (s - 8) * 32, bidx = prompt ? s : s - 8;
    float* vec = (float*)smem;
    float* vvb = (float*)(smem + 81920);
    float* rkb = (float*)(smem + 98304);
    float* ob = (float*)(smem + 98560);
    const float* sin_ = prompt ? nullptr : PIN(7) + (size_t)(bidx * 16 + h) * 4096;
    float* sout = P.out + (prompt ? O_PWKV : O_SWKV) + (size_t)(bidx * 16 + h) * 4096;
    const int cc = h * 64 + 4 * q;
    f32x4 S0 = (f32x4){0.f, 0.f, 0.f, 0.f}, S1 = S0;
    if (sin_) { S0 = *(const f32x4*)(sin_ + rp * 64 + 4 * q); S1 = *(const f32x4*)(sin_ + (rp + 32) * 64 + 4 * q); }
    const f32x4 kkw = *(const f32x4*)(PIN(39) + cc), kaw = *(const f32x4*)(PIN(40) + cc), rkw = *(const f32x4*)(PIN(41) + cc);
    const f32x4 gng = *(const f32x4*)(PIN(42) + cc), gnb = *(const f32x4*)(PIN(43) + cc);
    u32x2 rr, rk_, rv, re, ra, rg;
#define WKV_LOAD(c_) do { const size_t o_ = (size_t)(row0 + (c_) * 32 + rp) * 1024 + cc; rr = *(const u32x2*)(RO + o_); rk_ = *(const u32x2*)(Kk + o_); \
        rv = *(const u32x2*)(Vv + o_); re = *(const u32x2*)(Ee + o_); ra = *(const u32x2*)(Aa + o_); } while (0)
#define WKV_DERIVE(buf_) do { \
        const f32x4 rf = (f32x4){bflo(rr.x), bfhi(rr.x), bflo(rr.y), bfhi(rr.y)}, kf = (f32x4){bflo(rk_.x), bfhi(rk_.x), bflo(rk_.y), bfhi(rk_.y)}; \
        const f32x4 vf = (f32x4){bflo(rv.x), bfhi(rv.x), bflo(rv.y), bfhi(rv.y)}, ef = (f32x4){bflo(re.x), bfhi(re.x), bflo(re.y), bfhi(re.y)}; \
        const f32x4 af = (f32x4){bflo(ra.x), bfhi(ra.x), bflo(ra.y), bfhi(ra.y)}; \
        f32x4 kkv = kf * kkw; const float ss = red16(kkv[0] * kkv[0] + kkv[1] * kkv[1] + kkv[2] * kkv[2] + kkv[3] * kkv[3]); \
        const float inv = 1.f / fmaxf(sqrtf(ss), 1e-12f); kkv = kkv * inv; \
        const f32x4 km = kf * (1.f + (af - 1.f) * kaw); \
        f32x4 wv; wv[0] = __expf(-ef[0]); wv[1] = __expf(-ef[1]); wv[2] = __expf(-ef[2]); wv[3] = __expf(-ef[3]); \
        const f32x4 t3 = rf * km * rkw; const float rks = red16(t3[0] + t3[1] + t3[2] + t3[3]); \
        float* vb_ = vec + ((buf_) * 32 + rp) * 320 + 4 * q; \
        *(f32x4*)(vb_) = -kkv; *(f32x4*)(vb_ + 64) = wv; *(f32x4*)(vb_ + 128) = kkv * af; *(f32x4*)(vb_ + 192) = km; *(f32x4*)(vb_ + 256) = rf; \
        *(f32x4*)(vvb + ((buf_) * 32 + rp) * 64 + 4 * q) = vf; if (q == 0) rkb[(buf_) * 32 + rp] = rks; } while (0)
    __syncthreads();
    WKV_LOAD(0); WKV_DERIVE(0);
    __syncthreads();
    for (int c = 0; c < nch; ++c) {
        const int buf = c & 1;
        if (c + 1 < nch) WKV_LOAD(c + 1);
        rg = *(const u32x2*)(Gg + (size_t)(row0 + c * 32 + rp) * 1024 + cc);
        const float* vb = vec + buf * 32 * 320 + 4 * q; const float* vvp = vvb + buf * 32 * 64;
        f32x4 n4 = *(const f32x4*)(vb), w4 = *(const f32x4*)(vb + 64), b4 = *(const f32x4*)(vb + 128), k4 = *(const f32x4*)(vb + 192), r4 = *(const f32x4*)(vb + 256);
        float v0 = vvp[rp], v1 = vvp[rp + 32];
#pragma unroll 4
        for (int t = 0; t < 32; ++t) {
            const int tn = (t + 1) & 31;
            const f32x4 n4n = *(const f32x4*)(vb + tn * 320), w4n = *(const f32x4*)(vb + tn * 320 + 64), b4n = *(const f32x4*)(vb + tn * 320 + 128),
                        k4n = *(const f32x4*)(vb + tn * 320 + 192), r4n = *(const f32x4*)(vb + tn * 320 + 256);
            const float v0n = vvp[tn * 64 + rp], v1n = vvp[tn * 64 + rp + 32];
            const float sa0 = red16(S0[0] * n4[0] + S0[1] * n4[1] + S0[2] * n4[2] + S0[3] * n4[3]);
            const float sa1 = red16(S1[0] * n4[0] + S1[1] * n4[1] + S1[2] * n4[2] + S1[3] * n4[3]);
            S0 = S0 * w4 + (b4 * sa0 + k4 * v0);
            S1 = S1 * w4 + (b4 * sa1 + k4 * v1);
            const float o0 = red16(S0[0] * r4[0] + S0[1] * r4[1] + S0[2] * r4[2] + S0[3] * r4[3]);
            const float o1 = red16(S1[0] * r4[0] + S1[1] * r4[1] + S1[2] * r4[2] + S1[3] * r4[3]);
            if (q == 0) { ob[t * 64 + rp] = o0; ob[t * 64 + rp + 32] = o1; }
            n4 = n4n; w4 = w4n; b4 = b4n; k4 = k4n; r4 = r4n; v0 = v0n; v1 = v1n;
        }
        __syncthreads();
        {
            f32x4 o = *(const f32x4*)(ob + rp * 64 + 4 * q);
            const float mean = red16(o[0] + o[1] + o[2] + o[3]) * (1.f / 64.f); o = o - mean;
            const float var = red16(o[0] * o[0] + o[1] * o[1] + o[2] * o[2] + o[3] * o[3]) * (1.f / 64.f);
            const float rstd = rsqrtf(var + 64e-5f);
            const f32x4 vf = *(const f32x4*)(vvp + rp * 64 + 4 * q); const float rks = rkb[buf * 32 + rp];
            const f32x4 gf = (f32x4){bflo(rg.x), bfhi(rg.x), bflo(rg.y), bfhi(rg.y)};
            const f32x4 y = (o * rstd * gng + gnb + vf * rks) * gf;
            u32x2 st; st.x = pk2(y[0], y[1]); st.y = pk2(y[2], y[3]);
            if (!dry) *(u32x2*)(RO + (size_t)(row0 + c * 32 + rp) * 1024 + cc) = st;
        }
        if (c + 1 < nch) WKV_DERIVE(buf ^ 1);
        __syncthreads();
    }
    *(f32x4*)(sout + rp * 64 + 4 * q) = S0 * DBG_WKVSCALE; *(f32x4*)(sout + (rp + 32) * 64 + 4 * q) = S1 * DBG_WKVSCALE;
#undef WKV_LOAD
#undef WKV_DERIVE
}


DEV void wkv_half(int s, int h, int half, const KP& P, bf16_t* RO, const bf16_t* Kk, const bf16_t* Vv, const bf16_t* Ee, const bf16_t* Aa, const bf16_t* Gg, unsigned long long* xch, unsigned char* smem) {
    const int tid = ltid(), q = tid & 15, rp = tid >> 4;
    const bool prompt = s < 8; const int T = prompt ? 4096 : 32, nch = T / 32;
    const int row0 = prompt ? s * 4096 : MPROMPT + (s - 8) * 32, bidx = prompt ? s : s - 8;
    float* vec = (float*)smem;
    float* vvb = (float*)(smem + 81920);
    float* rkb = (float*)(smem + 98304);
    float* ob = (float*)(smem + 98560);
    float* statb = (float*)(smem + 106752);
    const int crow = half * 32;
    const float* sin_ = prompt ? nullptr : PIN(7) + (size_t)(bidx * 16 + h) * 4096;
    float* sout = P.out + (prompt ? O_PWKV : O_SWKV) + (size_t)(bidx * 16 + h) * 4096;
    const size_t gbase = prompt ? (size_t)(s * 16 + h) * 4096 : (size_t)128 * 4096 + (size_t)((s - 8) * 16 + h) * 32;
    const int cc = h * 64 + 4 * q, c2 = h * 64 + crow + 2 * q;
    f32x4 S0 = (f32x4){0.f, 0.f, 0.f, 0.f};
    if (sin_) S0 = *(const f32x4*)(sin_ + (crow + rp) * 64 + 4 * q);
    const f32x4 kkw = *(const f32x4*)(PIN(39) + cc), kaw = *(const f32x4*)(PIN(40) + cc), rkw = *(const f32x4*)(PIN(41) + cc);
    const float gw0 = PIN(42)[c2], gw1 = PIN(42)[c2 + 1], gb0 = PIN(43)[c2], gb1 = PIN(43)[c2 + 1];
    u32x2 rr, rk_, rv, re, ra; unsigned rgp = 0u;
#define WKV_LOAD(c_) do { const size_t o_ = (size_t)(row0 + (c_) * 32 + rp) * 1024 + cc; rr = *(const u32x2*)(RO + o_); rk_ = *(const u32x2*)(Kk + o_); \
        rv = *(const u32x2*)(Vv + o_); re = *(const u32x2*)(Ee + o_); ra = *(const u32x2*)(Aa + o_); } while (0)
#define WKV_DERIVE(buf_) do { \
        const f32x4 rf = (f32x4){bflo(rr.x), bfhi(rr.x), bflo(rr.y), bfhi(rr.y)}, kf = (f32x4){bflo(rk_.x), bfhi(rk_.x), bflo(rk_.y), bfhi(rk_.y)}; \
        const f32x4 vf = (f32x4){bflo(rv.x), bfhi(rv.x), bflo(rv.y), bfhi(rv.y)}, ef = (f32x4){bflo(re.x), bfhi(re.x), bflo(re.y), bfhi(re.y)}; \
        const f32x4 af = (f32x4){bflo(ra.x), bfhi(ra.x), bflo(ra.y), bfhi(ra.y)}; \
        f32x4 kkv = kf * kkw; const float ss = red16(kkv[0] * kkv[0] + kkv[1] * kkv[1] + kkv[2] * kkv[2] + kkv[3] * kkv[3]); \
        const float inv = 1.f / fmaxf(sqrtf(ss), 1e-12f); kkv = kkv * inv; \
        const f32x4 km = kf * (1.f + (af - 1.f) * kaw); \
        f32x4 wv; wv[0] = __expf(-ef[0]); wv[1] = __expf(-ef[1]); wv[2] = __expf(-ef[2]); wv[3] = __expf(-ef[3]); \
        const f32x4 t3 = rf * km * rkw; const float rks = red16(t3[0] + t3[1] + t3[2] + t3[3]); \
        float* vb_ = vec + ((buf_) * 32 + rp) * 320 + 4 * q; \
        *(f32x4*)(vb_) = -kkv; *(f32x4*)(vb_ + 64) = wv; *(f32x4*)(vb_ + 128) = kkv * af; *(f32x4*)(vb_ + 192) = km; *(f32x4*)(vb_ + 256) = rf; \
        *(f32x4*)(vvb + ((buf_) * 32 + rp) * 64 + 4 * q) = vf; if (q == 0) rkb[(buf_) * 32 + rp] = rks; } while (0)
#define WKV_FINAL(cc_, fb_) do { \
        unsigned long long* pg_ = xch + ((gbase + (size_t)((cc_) * 32 + rp)) * 2 + (half ^ 1)); unsigned long long pv_; unsigned sp_ = 0u; \
        do { pv_ = __hip_atomic_load(pg_, __ATOMIC_RELAXED, __HIP_MEMORY_SCOPE_AGENT); if ((unsigned)pv_ != 0xFFFFFFFFu) break; __builtin_amdgcn_s_sleep(1); } while (++sp_ < (1u << 22)); \
        const float sm_ = statb[((fb_) * 32 + rp) * 2] + __uint_as_float((unsigned)pv_), sq_ = statb[((fb_) * 32 + rp) * 2 + 1] + __uint_as_float((unsigned)(pv_ >> 32)); \
        const float mean_ = sm_ * (1.f / 64.f), var_ = fmaxf(sq_ * (1.f / 64.f) - mean_ * mean_, 0.f), rstd_ = rsqrtf(var_ + 64e-5f); \
        const float o0_ = ob[((fb_) * 32 + rp) * 32 + 2 * q], o1_ = ob[((fb_) * 32 + rp) * 32 + 2 * q + 1]; \
        const float v0_ = vvb[((fb_) * 32 + rp) * 64 + crow + 2 * q], v1_ = vvb[((fb_) * 32 + rp) * 64 + crow + 2 * q + 1], rks_ = rkb[(fb_) * 32 + rp]; \
        const float y0_ = ((o0_ - mean_) * rstd_ * gw0 + gb0 + v0_ * rks_) * bflo(rgp), y1_ = ((o1_ - mean_) * rstd_ * gw1 + gb1 + v1_ * rks_) * bfhi(rgp); \
        *(unsigned*)(RO + (size_t)(row0 + (cc_) * 32 + rp) * 1024 + c2) = pk2(y0_, y1_); } while (0)
    __syncthreads();
    WKV_LOAD(0); WKV_DERIVE(0);
    __syncthreads();
    for (int c = 0; c < nch; ++c) {
        const int buf = c & 1;
        if (c + 1 < nch) WKV_LOAD(c + 1);
        if (c > 0) rgp = *(const unsigned*)(Gg + (size_t)(row0 + (c - 1) * 32 + rp) * 1024 + c2);
        const float* vb = vec + buf * 32 * 320 + 4 * q; const float* vvp = vvb + buf * 32 * 64 + crow;
        f32x4 n4 = *(const f32x4*)(vb), w4 = *(const f32x4*)(vb + 64), b4 = *(const f32x4*)(vb + 128), k4 = *(const f32x4*)(vb + 192), r4 = *(const f32x4*)(vb + 256);
        float v0 = vvp[rp];
#pragma unroll 4
        for (int t = 0; t < 32; ++t) {
            const int tn = (t + 1) & 31;
            const f32x4 n4n = *(const f32x4*)(vb + tn * 320), w4n = *(const f32x4*)(vb + tn * 320 + 64), b4n = *(const f32x4*)(vb + tn * 320 + 128),
                        k4n = *(const f32x4*)(vb + tn * 320 + 192), r4n = *(const f32x4*)(vb + tn * 320 + 256);
            const float v0n = vvp[tn * 64 + rp];
            const float sa0 = red16(S0[0] * n4[0] + S0[1] * n4[1] + S0[2] * n4[2] + S0[3] * n4[3]);
            S0 = S0 * w4 + (b4 * sa0 + k4 * v0);
            const float o0 = red16(S0[0] * r4[0] + S0[1] * r4[1] + S0[2] * r4[2] + S0[3] * r4[3]);
            if (q == 0) ob[(buf * 32 + t) * 32 + rp] = o0;
            n4 = n4n; w4 = w4n; b4 = b4n; k4 = k4n; r4 = r4n; v0 = v0n;
        }
        __syncthreads();
        {
            const float o0 = ob[(buf * 32 + rp) * 32 + 2 * q], o1 = ob[(buf * 32 + rp) * 32 + 2 * q + 1];
            const float sm = red16(o0 + o1), sq = red16(o0 * o0 + o1 * o1);
            if (q == 0) { statb[(buf * 32 + rp) * 2] = sm; statb[(buf * 32 + rp) * 2 + 1] = sq;
                __hip_atomic_store(xch + ((gbase + (size_t)(c * 32 + rp)) * 2 + half), (unsigned long long)__float_as_uint(sm) | ((unsigned long long)__float_as_uint(sq) << 32), __ATOMIC_RELAXED, __HIP_MEMORY_SCOPE_AGENT); }
        }
        if (c > 0) WKV_FINAL(c - 1, buf ^ 1);
        __syncthreads();
        if (c + 1 < nch) WKV_DERIVE(buf ^ 1);
        __syncthreads();
    }
    rgp = *(const unsigned*)(Gg + (size_t)(row0 + (nch - 1) * 32 + rp) * 1024 + c2);
    WKV_FINAL(nch - 1, (nch - 1) & 1);
    *(f32x4*)(sout + (crow + rp) * 64 + 4 * q) = S0;
#undef WKV_LOAD
#undef WKV_DERIVE
#undef WKV_FINAL
}

#define XB_TMO      128
#define XB_XCNT(j)  (256  + 64 * (j))
#define XB_XSUB(j)  (1280 + 64 * (j))
#define XB_XGEN(j)  (2304 + 64 * (j))
#define XB_TOP      3328
#define XB_TOPGEN   3392
#define XCD_BAR_WORDS 3456
#define XB_SPIN_CAP (1u << 22)
DEV unsigned xb_ld(unsigned* p)              { return __hip_atomic_load(p, __ATOMIC_RELAXED, __HIP_MEMORY_SCOPE_AGENT); }
DEV unsigned xb_add(unsigned* p, unsigned v) { return __hip_atomic_fetch_add(p, v, __ATOMIC_RELAXED, __HIP_MEMORY_SCOPE_AGENT); }
DEV unsigned xb_xcc_id() { return (unsigned)__builtin_amdgcn_s_getreg((3 << 11) | 20) & 0xFu; }
#define XB_SPIN(cond, bar) do { unsigned _sp = 0; while (cond) { __builtin_amdgcn_s_sleep(1); \
    if ((++_sp & 255u) == 0u) { if (xb_ld(&(bar)[XB_TMO])) break; if (_sp > XB_SPIN_CAP) { atomicAdd(&(bar)[XB_TMO], 1u); break; } } } } while (0)
struct XcdBarrier { unsigned* bar; unsigned x; volatile LAS unsigned* st; };
DEV XcdBarrier xcd_barrier_post(unsigned* bar, volatile LAS unsigned* st) {
    XcdBarrier b; b.bar = bar; b.x = xb_xcc_id(); b.st = st;
    if (threadIdx.x == 0) (void)xb_add(&bar[XB_XCNT(b.x)], 1u);
    return b;
}
DEV void xcd_barrier_complete(unsigned* bar, unsigned x, unsigned& nloc, unsigned& nx) {
    const unsigned G = gridDim.x * gridDim.y * gridDim.z;
    unsigned sum, cnt, mine, sp = 0u;
    for (;;) {
        sum = 0u; cnt = 0u; mine = 0u;
#pragma unroll
        for (unsigned j = 0; j < 16; ++j) { const unsigned c = xb_ld(&bar[XB_XCNT(j)]); sum += c; cnt += (c > 0u) ? 1u : 0u; mine = (j == x) ? c : mine; }
        if (sum == G) break;
        __builtin_amdgcn_s_sleep(1);
        if ((++sp & 255u) == 0u) { if (xb_ld(&bar[XB_TMO])) break; if (sp > XB_SPIN_CAP) { atomicAdd(&bar[XB_TMO], 1u); break; } }
    }
    nloc = mine > 0u ? mine : 1u; nx = cnt > 0u ? cnt : 1u;
}
DEV void xcd_barrier(const XcdBarrier& b) {
    asm volatile("s_waitcnt vmcnt(0)" ::: "memory");
    __syncthreads();
    if (threadIdx.x == 0) {
        unsigned* bar = b.bar;
        __builtin_amdgcn_s_waitcnt(0);
        unsigned nloc = b.st[0], nx = b.st[1];
        if (nloc == 0u) { xcd_barrier_complete(bar, b.x, nloc, nx); b.st[0] = nloc; b.st[1] = nx; }
        const unsigned old = xb_add(&bar[XB_XSUB(b.x)], 1u);
        const unsigned gen = old / nloc;
        if (old + 1u == (gen + 1u) * nloc) {
            __builtin_amdgcn_fence(__ATOMIC_RELEASE, "agent");
            asm volatile("s_waitcnt vmcnt(0)" ::: "memory");
            const unsigned og = xb_add(&bar[XB_TOP], 1u);
            const unsigned tg = og / nx;
            if (og + 1u == (tg + 1u) * nx) xb_add(&bar[XB_TOPGEN], 1u);
            else XB_SPIN(xb_ld(&bar[XB_TOPGEN]) == tg, bar);
            __builtin_amdgcn_fence(__ATOMIC_ACQUIRE, "agent");
            xb_add(&bar[XB_XGEN(b.x)], 1u);
            asm volatile("s_waitcnt vmcnt(0)" ::: "memory");
        } else {
            XB_SPIN(xb_ld(&bar[XB_XGEN(b.x)]) == gen, bar);
            __builtin_amdgcn_fence(__ATOMIC_ACQUIRE, "agent");
            asm volatile("s_waitcnt vmcnt(0)" ::: "memory");
        }
    }
    __syncthreads();
}

__global__ void __launch_bounds__(NTHR, 2) mega(KP P) {
    extern __shared__ __attribute__((aligned(16))) unsigned char smem[];
    cg::grid_group grid = cg::this_grid();
    unsigned char* ws = P.ws;
    bf16_t* W = (bf16_t*)ws;
    bf16_t* KB = (bf16_t*)(ws + WS_KB); bf16_t* VT = (bf16_t*)(ws + WS_VT);
    bf16_t* XB = (bf16_t*)(ws + WS_XB); bf16_t* A1 = (bf16_t*)(ws + WS_A1); bf16_t* A2 = (bf16_t*)(ws + WS_A2);
    bf16_t* A3 = (bf16_t*)(ws + WS_A3); bf16_t* A4 = (bf16_t*)(ws + WS_A4); bf16_t* HL = (bf16_t*)(ws + WS_HL);
    bf16_t* D1 = (bf16_t*)P.out; bf16_t* D2 = D1 + E_EL;
    {
        if (threadIdx.x == 0) { *(volatile LAS unsigned*)((LAS unsigned char*)smem + LDS_BYTES - 16) = 0u; *(volatile LAS unsigned*)((LAS unsigned char*)smem + LDS_BYTES - 12) = 0u; }
        __syncthreads();
    }
    const XcdBarrier xbar = xcd_barrier_post((unsigned*)(ws + WS_END), (volatile LAS unsigned*)((LAS unsigned char*)smem + LDS_BYTES - 16));
    for (int ph = P.ph_lo; ph < P.ph_hi; ++ph) {
        GD d; d.mode = -1; d.coff = 0; d.ep = EpiP{nullptr, nullptr, nullptr, nullptr, nullptr, nullptr, nullptr, 0, 0.f};
        int lnidx = -1; int attl = -1;
#define GEMM_SET(A0_, A1_, Bt_, lda_, K_, nt0_, M_, N_, mode_) do { d.g = pg8::Gemm{A0_, A1_, Bt_, lda_, K_, nt0_, M_, N_}; d.mode = mode_; } while (0)
        switch (ph) {
            case 0: prep_phase(P, smem, 0, (int)blockIdx.x, (int)gridDim.x); break;
            case 1: { GD d2; d2.coff = 128; d2.mode = 5; d2.g = pg8::Gemm{A4, A4, W + W_KV, 1024, 1024, 16, 2048, 4096};
                      d2.ep = EpiP{KB, VT, nullptr, nullptr, P.out, nullptr, nullptr, 0, 0.f}; run_gemm(d2, smem); }
            case 12: case 15: case 27: { const int wi = (ph == 1) ? 0 : (ph == 12 ? 1 : (ph == 15 ? 2 : 3));
                      GEMM_SET(XB, XB, W + W_UP + (size_t)wi * 5632 * 1024, 1024, 1024, 16, MTOK, 5632, 1); d.ep.o0 = A1; } break;
            case 2: case 13: case 16: case 28: { const int wi = (ph == 2) ? 0 : (ph == 13 ? 1 : (ph == 16 ? 2 : 3));
                      GEMM_SET(A1, A1, W + W_DN + (size_t)wi * 1024 * 2816, 2816, 2816, 44, MTOK, 1024, 2); d.ep.o0 = XB; d.ep.s = 0.5f; } break;
            case 3: lnidx = 0; break; case 7: lnidx = 1; break; case 11: lnidx = 2; break; case 14: lnidx = 3; break;
            case 17: lnidx = 4; break; case 22: lnidx = 5; break; case 26: lnidx = 6; break; case 29: lnidx = 7; break;
            case 4: GEMM_SET(XB, XB, W + W_IN, 1024, 1024, 16, MTOK, 3072, 0); d.ep.o0 = A1; d.ep.ldc = 3072; break;
            case 5: for (int rep = 0; rep < DBG_MIXREP; ++rep) for (int job = blockIdx.x; job < 288; job += gridDim.x) {
                        if (job < 32) ret_job(job >> 2, job & 3, P, A1, A4, smem);
                        else if (job < 96) lru_job((job - 32) >> 3, (job - 32) & 7, P, A1, A4, smem);
                        else if (job < 160) ret_job(8 + ((job - 96) >> 2), (job - 96) & 3, P, A1, A4, smem);
                        else lru_job(8 + ((job - 160) >> 3), (job - 160) & 7, P, A1, A4, smem);
                    }
                    if (gridDim.x > 128) { if (blockIdx.x >= 96) { __syncthreads(); prep_phase(P, smem, 1, (int)blockIdx.x - 96, (int)gridDim.x - 96); } }
                    else { __syncthreads(); prep_phase(P, smem, 1, (int)blockIdx.x, (int)gridDim.x); }
                    break;
            case 6: GEMM_SET(A4, A4, W + W_O0, 1024, 1024, 16, MTOK, 1024, 2); d.ep.o0 = XB; d.ep.s = 1.f; break;
            case 8: GEMM_SET(XB, XB, W + W_XQ, 1024, 1024, 16, MTOK, 1024, 0); d.ep.o0 = A1; d.ep.ldc = 1024; break;
            case 9: for (int rep = 0; rep < DBG_ATTREP; ++rep) attn_phase(A1, KB, VT, A2, smem); break;
            case 10: GEMM_SET(A2, A2, W + W_XO, 1024, 1024, 16, MTOK, 1024, 2); d.ep.o0 = XB; d.ep.s = 1.f; break;
            case 18: GEMM_SET(XB, A4, W + W_P1, 1024, 2048, 16, MTOK, 3328, 3); d.ep.o0 = A1; d.ep.o1 = A2; d.ep.o2 = A3; d.ep.o3 = HL; break;
            case 19: GEMM_SET(HL, HL, W + W_L2, 256, 256, 4, MTOK, 3072, 4); d.ep.o0 = D1; d.ep.o1 = D2; d.ep.o2 = A4; d.ep.v0 = PIN(31); d.ep.v1 = PIN(34); break;
            case 20: if (gridDim.x == 256) {
                        unsigned long long* xch = (unsigned long long*)(ws + WS_END + 16384);
                        const int hf = blockIdx.x & 1, pj = blockIdx.x >> 1;
                        wkv_half(pj >> 4, pj & 15, hf, P, A1, A2, A3, D1, D2, A4, xch, smem);
                        wkv_half(8 + (pj >> 4), pj & 15, hf, P, A1, A2, A3, D1, D2, A4, xch, smem);
                        wkv_half(8 + ((pj + 128) >> 4), (pj + 128) & 15, hf, P, A1, A2, A3, D1, D2, A4, xch, smem);
                    } else for (int job = blockIdx.x; job < 384; job += gridDim.x) {
                        if (job < 128) wkv_job(job >> 4, job & 15, P, A1, A2, A3, D1, D2, A4, smem, false);
                        else wkv_job(8 + ((job - 128) >> 4), (job - 128) & 15, P, A1, A2, A3, D1, D2, A4, smem, false);
                    } break;
            case 21: GEMM_SET(A1, A1, W + W_O1, 1024, 1024, 16, MTOK, 1024, 2); d.ep.o0 = XB; d.ep.s = 1.f; break;
            case 23: GEMM_SET(XB, XB, W + W_XQ + 1048576, 1024, 1024, 16, MTOK, 1024, 0); d.ep.o0 = A2; d.ep.ldc = 1024; break;
            case 24: attn_phase(A2, KB + (size_t)24 * 256 * 1024, VT + (size_t)24 * 256 * 1024, A3, smem); break;
            case 25: GEMM_SET(A3, A3, W + W_XO + 1048576, 1024, 1024, 16, MTOK, 1024, 2); d.ep.o0 = XB; d.ep.s = 1.f; break;
            default: break;
        }
        if (d.mode >= 0) run_gemm(d, smem);
        if (DBG_GREP > 1 && ph == 4) run_gemm(d, smem);
        if (DBG_LNREP > 1 && lnidx == 0) ln_phase(XB, PIN(10) + lnidx * 1024, PIN(11) + lnidx * 1024, nullptr, nullptr, PIN(6), P.out, P.ph_hi < 1000);
        if (lnidx >= 0) ln_phase(XB, PIN(10) + lnidx * 1024, PIN(11) + lnidx * 1024, lnidx == 4 ? A4 : nullptr, lnidx == 7 ? P.out + O_Y : nullptr, PIN(6), P.out, lnidx == 7);
        (void)attl;
        if (ph == 6) for (int rep = 0; rep < DBG_SYNCREP; ++rep) { __threadfence(); grid.sync(); __builtin_amdgcn_fence(__ATOMIC_ACQUIRE, "agent"); asm volatile("buffer_inv sc1" ::: "memory"); }
        if (ph + 1 < P.ph_hi) {
            if (P.ph_lo == 0x7fffffff) grid.sync();
            xcd_barrier(xbar);
        }
    }
}

extern "C" void kernel_launch(void* const* d_in, const int* in_sizes, int n_in, void* d_out, int out_size, void* d_ws, size_t ws_size, hipStream_t stream) {
    static int grid_blocks = 0;
    if (grid_blocks == 0) {
        if (n_in != 45 || ws_size < WS_END + 16384 + 8519680) { fprintf(stderr, "kernel_launch: unexpected n_in %d or ws_size %zu (< %zu)\n", n_in, ws_size, (size_t)WS_END); grid_blocks = -1; return; }
        int dev = 0, cus = 0, per_cu = 0;
        hipGetDevice(&dev);
        hipDeviceGetAttribute(&cus, hipDeviceAttributeMultiprocessorCount, dev);
        if (hipFuncSetAttribute((const void*)mega, hipFuncAttributeMaxDynamicSharedMemorySize, LDS_BYTES) != hipSuccess) { fprintf(stderr, "kernel_launch: hipFuncSetAttribute failed\n"); grid_blocks = -1; return; }
        hipOccupancyMaxActiveBlocksPerMultiprocessor(&per_cu, (const void*)mega, NTHR, LDS_BYTES);
        if (per_cu < 1) { fprintf(stderr, "kernel_launch: occupancy query returned %d\n", per_cu); per_cu = 1; }
        (void)hipGetLastError();
        grid_blocks = cus * per_cu;
    }
    if (grid_blocks < 0) return;
    if (hipMemsetAsync((char*)d_ws + WS_END, 0, 16384, stream) != hipSuccess) { fprintf(stderr, "kernel_launch: memset of the barrier word failed\n"); return; }
    if (hipMemsetAsync((char*)d_ws + WS_END + 16384, 0xFF, 8519680, stream) != hipSuccess) { fprintf(stderr, "kernel_launch: memset of the exchange granules failed\n"); return; }
    KP p{};
    for (int i = 0; i < 45; ++i) p.in[i] = (const float*)d_in[i];
    p.out = (float*)d_out; p.ws = (unsigned char*)d_ws; p.ph_lo = 0; p.ph_hi = 30;
    void* args[] = {&p};
    hipError_t e = hipLaunchCooperativeKernel((const void*)mega, dim3(grid_blocks), dim3(NTHR), args, LDS_BYTES, stream);
    if (e != hipSuccess) fprintf(stderr, "cooperative launch failed: %s (grid %d)\n", hipGetErrorString(e), grid_blocks);
}
```
